# Optimizing an MI355X kernel written in HIP

```python
import math
import jax, jax.numpy as jnp
from jax import lax
import numpy as np

D_MODEL = 1024
BATCH = 4
SEQ = 4096
DEPTH = 1

ATTN_HEADS = 8
HEAD_DIM = 64
ATTN_WIDTH = ATTN_HEADS * HEAD_DIM
IDX_HEADS = 8
IDX_DIM = 64
TOPK_MAX = 256
Q_BLOCK = 128
POOL_WINDOWS = (2, 4, 8, 16)
POOL_GROUPS = len(POOL_WINDOWS)
POOL_WIDTH = D_MODEL - ATTN_WIDTH
POOL_GROUP_DIM = POOL_WIDTH // POOL_GROUPS
REL_BUCKETS = 32
REL_MAX_DIST = 128
N_GROUPS = 4
EXPERTS_PER_GROUP = 8
N_EXPERTS = N_GROUPS * EXPERTS_PER_GROUP
TOP_K_INNER = 2
D_EXPERT = 256
LN_EPS = 1e-5
DEEPNORM_ALPHA = (2 * DEPTH) ** 0.25
DEEPNORM_BETA = (8 * DEPTH) ** -0.25
Q_OFF = 0
K_OFF = Q_OFF + ATTN_WIDTH
V_OFF = K_OFF + ATTN_WIDTH
IQ_OFF = V_OFF + ATTN_WIDTH
IK_OFF = IQ_OFF + IDX_HEADS * IDX_DIM
IW_OFF = IK_OFF + IDX_DIM
P_OFF = IW_OFF + IDX_HEADS
IN_WIDTH = P_OFF + POOL_WIDTH

kernel_name = 'hybrid_dsa_pool_hmoe_deepnorm'


def layer_norm(x, g, b):
    xf = x.astype(jnp.float32)
    mu = jnp.mean(xf, axis=-1, keepdims=True)
    var = jnp.mean(jnp.square(xf - mu), axis=-1, keepdims=True)
    y = (xf - mu) * lax.rsqrt(var + LN_EPS) * g.astype(jnp.float32) + b.astype(jnp.float32)
    return y.astype(x.dtype)


def rel_bucket(dist):
    max_exact = REL_BUCKETS // 2
    n = jnp.maximum(dist, 0)
    nf = jnp.maximum(n, 1).astype(jnp.float32)
    large = max_exact + (jnp.log(nf / max_exact) / math.log(REL_MAX_DIST / max_exact)
                         * (REL_BUCKETS - max_exact)).astype(jnp.int32)
    large = jnp.minimum(large, REL_BUCKETS - 1)
    return jnp.where(n < max_exact, n, large)


def dsa_attention(q, k, v, iq, ik, iw, rel_bias):
    B, S = q.shape[0], q.shape[1]
    k_top = min(TOPK_MAX, S // 4)
    n_blocks = S // Q_BLOCK
    key_pos = jnp.arange(S)

    def block(i):
        start = i * Q_BLOCK
        qb = lax.dynamic_slice_in_dim(q, start, Q_BLOCK, axis=1)
        iqb = lax.dynamic_slice_in_dim(iq, start, Q_BLOCK, axis=1)
        iwb = lax.dynamic_slice_in_dim(iw, start, Q_BLOCK, axis=1)
        q_pos = start + jnp.arange(Q_BLOCK)
        dots = jnp.einsum('bqjd,bsd->bqjs', iqb, ik).astype(jnp.float32) * (IDX_DIM ** -0.5)
        score = jnp.einsum('bqj,bqjs->bqs', iwb.astype(jnp.float32), jax.nn.relu(dots))
        causal = key_pos[None, :] <= q_pos[:, None]
        score = jnp.where(causal[None], score, -jnp.inf)
        _, sel = lax.top_k(score, k_top)
        valid = sel <= q_pos[None, :, None]
        k_sel = jax.vmap(lambda kb, ib: kb[ib])(k, sel).reshape(B, Q_BLOCK, k_top, ATTN_HEADS, HEAD_DIM)
        v_sel = jax.vmap(lambda vb, ib: vb[ib])(v, sel).reshape(B, Q_BLOCK, k_top, ATTN_HEADS, HEAD_DIM)
        logits = jnp.einsum('bqhd,bqkhd->bqhk', qb, k_sel).astype(jnp.float32) * (HEAD_DIM ** -0.5)
        bias = rel_bias[rel_bucket(q_pos[None, :, None] - sel)]
        logits = logits + jnp.moveaxis(bias, -1, 2).astype(jnp.float32)
        logits = jnp.where(valid[:, :, None, :], logits, -jnp.inf)
        p = jax.nn.softmax(logits, axis=-1).astype(v.dtype)
        return jnp.einsum('bqhk,bqkhd->bqhd', p, v_sel)

    out = lax.map(block, jnp.arange(n_blocks))
    return jnp.moveaxis(out, 0, 1).reshape(B, S, ATTN_WIDTH)


def pool_mixer(u, w_pool, pool_scale):
    B, S = u.shape[0], u.shape[1]
    ug = u.reshape(B, S, POOL_GROUPS, POOL_GROUP_DIM)
    pos = jnp.arange(S)
    outs = []
    for g, w in enumerate(POOL_WINDOWS):
        ch = ug[:, :, g].astype(jnp.float32)
        c = lax.cumsum(ch, axis=1)
        c_shift = jnp.pad(c, ((0, 0), (w, 0), (0, 0)))[:, :S]
        count = jnp.minimum(pos + 1, w).astype(jnp.float32)[None, :, None]
        outs.append((c - c_shift) / count - ch)
    pooled = jnp.stack(outs, axis=2).astype(u.dtype)
    mixed = jnp.einsum('bsgc,gcd->bsgd', pooled, w_pool)
    return mixed.reshape(B, S, POOL_WIDTH) * pool_scale


def hier_moe(h, w_r1, b_r1, w_r2, b_r2, w_gate, w_up, w_down):
    B, S, D = h.shape
    t = h.reshape(-1, D)
    pg = jax.nn.softmax((t @ w_r1).astype(jnp.float32) + b_r1.astype(jnp.float32), axis=-1)
    pg_top, g = lax.top_k(pg, 1)
    lf = ((t @ w_r2).astype(jnp.float32) + b_r2.astype(jnp.float32)).reshape(-1, N_GROUPS, EXPERTS_PER_GROUP)
    lf_g = jnp.take_along_axis(lf, g[:, :, None], axis=1)[:, 0]
    pf = jax.nn.softmax(lf_g, axis=-1)
    pe, e_local = lax.top_k(pf, TOP_K_INNER)
    weights = pg_top * pe / jnp.sum(pe, axis=-1, keepdims=True)
    eid = g * EXPERTS_PER_GROUP + e_local
    combine = jnp.einsum('tk,tke->te', weights,
                         jax.nn.one_hot(eid, N_EXPERTS, dtype=jnp.float32)).astype(h.dtype)
    y = jnp.zeros_like(t)
    for e in range(N_EXPERTS):
        a = jax.nn.silu(t @ w_gate[e]) * (t @ w_up[e])
        y = y + combine[:, e:e + 1] * (a @ w_down[e])
    return y.reshape(B, S, D)


def setup_inputs(seed: int = 0) -> dict:
    key = jax.random.key(seed)
    ks = jax.random.split(key, 17)
    nrm = lambda k, shape, s: jax.random.normal(k, shape, jnp.float32) * s
    col_scale = jnp.ones((IN_WIDTH,), jnp.float32).at[V_OFF:IQ_OFF].set(DEEPNORM_BETA)
    return {
        'x': nrm(ks[0], (BATCH, SEQ, D_MODEL), 1.0),
        'w_in': nrm(ks[1], (DEPTH, D_MODEL, IN_WIDTH), D_MODEL ** -0.5) * col_scale,
        'w_pool': nrm(ks[2], (DEPTH, POOL_GROUPS, POOL_GROUP_DIM, POOL_GROUP_DIM), POOL_GROUP_DIM ** -0.5),
        'pool_scale': 1.0 + nrm(ks[3], (DEPTH, POOL_WIDTH), 0.05),
        'w_out': nrm(ks[4], (DEPTH, D_MODEL, D_MODEL), D_MODEL ** -0.5) * DEEPNORM_BETA,
        'rel_bias': nrm(ks[5], (REL_BUCKETS, ATTN_HEADS), 0.5),
        'ln1_g': 1.0 + nrm(ks[6], (DEPTH, D_MODEL), 0.05),
        'ln1_b': nrm(ks[7], (DEPTH, D_MODEL), 0.02),
        'w_r1': nrm(ks[8], (DEPTH, D_MODEL, N_GROUPS), D_MODEL ** -0.5),
        'b_r1': nrm(ks[9], (DEPTH, N_GROUPS), 0.01),
        'w_r2': nrm(ks[10], (DEPTH, D_MODEL, N_EXPERTS), D_MODEL ** -0.5),
        'b_r2': nrm(ks[11], (DEPTH, N_EXPERTS), 0.01),
        'w_gate': nrm(ks[12], (DEPTH, N_EXPERTS, D_MODEL, D_EXPERT), D_MODEL ** -0.5),
        'w_up': nrm(ks[13], (DEPTH, N_EXPERTS, D_MODEL, D_EXPERT), D_MODEL ** -0.5),
        'w_down': nrm(ks[14], (DEPTH, N_EXPERTS, D_EXPERT, D_MODEL), D_EXPERT ** -0.5) * DEEPNORM_BETA,
        'ln2_g': 1.0 + nrm(ks[15], (DEPTH, D_MODEL), 0.05),
        'ln2_b': nrm(ks[16], (DEPTH, D_MODEL), 0.02),
    }


def reference(x, w_in, w_pool, pool_scale, w_out, rel_bias, ln1_g, ln1_b, w_r1, b_r1, w_r2, b_r2,
              w_gate, w_up, w_down, ln2_g, ln2_b):
    B, S = x.shape[0], x.shape[1]
    h = x
    for l in range(DEPTH):
        proj = h @ w_in[l]
        q = proj[..., Q_OFF:K_OFF].reshape(B, S, ATTN_HEADS, HEAD_DIM)
        k = proj[..., K_OFF:V_OFF]
        v = proj[..., V_OFF:IQ_OFF]
        iq = proj[..., IQ_OFF:IK_OFF].reshape(B, S, IDX_HEADS, IDX_DIM)
        ik = proj[..., IK_OFF:IW_OFF]
        iw = proj[..., IW_OFF:P_OFF] * (IDX_HEADS ** -0.5)
        u = proj[..., P_OFF:IN_WIDTH]
        attn = dsa_attention(q, k, v, iq, ik, iw, rel_bias)
        pooled = pool_mixer(u, w_pool[l], pool_scale[l])
        mix = jnp.concatenate([attn, pooled], axis=-1) @ w_out[l]
        h = layer_norm(DEEPNORM_ALPHA * h + mix, ln1_g[l], ln1_b[l])
        ffn = hier_moe(h, w_r1[l], b_r1[l], w_r2[l], b_r2[l], w_gate[l], w_up[l], w_down[l])
        h = layer_norm(DEEPNORM_ALPHA * h + ffn, ln2_g[l], ln2_b[l])
    return h
```

```cpp
#include <hip/hip_runtime.h>
#include <hip/hip_bf16.h>
#include <cstdio>
#include <cstdint>
#include <cmath>

#ifndef MK_N_LAUNCHES
#define MK_N_LAUNCHES 1
#endif

constexpr int BATCH = 4, SEQ = 4096, DM = 1024, M = BATCH * SEQ;
constexpr int AW = 512;
constexpr int NIN = 2816;
constexpr int IN_W = 2632, P_OFF = 2120, IK_OFF = 2048, IW_OFF = 2112;
constexpr int NEXP = 32, DEXP = 256;
constexpr int MAXROWS = 40960;
constexpr float LN_EPS = 1e-5f;
constexpr float ALPHA = 1.189207115002721f;
constexpr float LOG2E = 1.4426950408889634f;
constexpr float QSCALE = 0.125f * LOG2E;

constexpr size_t MiB = 1u << 20;
constexpr size_t WS_CTL = 0, CTL_ZERO_BYTES = 1 * MiB;
constexpr size_t WS_IW = 1 * MiB;
constexpr size_t WS_RE = 1 * MiB + 512 * 1024;
constexpr size_t WS_RW = WS_RE + 128 * 1024;
constexpr size_t WS_POS = WS_RW + 128 * 1024;
constexpr size_t WS_WROW = WS_POS + 128 * 1024;
constexpr size_t WS_WRT = 3 * MiB;
constexpr size_t WS_BIAS = 3 * MiB + 256 * 1024;
constexpr size_t WS_WOUT = 4 * MiB;
constexpr size_t WS_WPBD = 6 * MiB;
constexpr size_t WS_WGU = 8 * MiB;
constexpr size_t WS_WD = 40 * MiB;
constexpr size_t WS_WIN = 56 * MiB;
constexpr size_t WS_XB = 64 * MiB;
constexpr size_t WS_Q = 96 * MiB;
constexpr size_t WS_K = 112 * MiB, WS_V = 128 * MiB, WS_IQ = 144 * MiB, WS_U = 160 * MiB;
constexpr size_t WS_IK = 176 * MiB;
constexpr size_t WS_MASK = 178 * MiB;
constexpr size_t WS_POOLED = 186 * MiB;
constexpr size_t WS_AP = 202 * MiB;
constexpr size_t WS_MIX = 64 * MiB;
constexpr size_t WS_H1B = 128 * MiB;
constexpr size_t WS_ACT = 160 * MiB;
constexpr size_t WS_YS = 64 * MiB;
constexpr size_t WS_END = 256 * MiB;
constexpr int CW_BAR = 4096, CW_CNT = 8192, CW_CUR = 8192 + 64, CW_ROWIDX = 16384;
static_assert((CW_ROWIDX + MAXROWS) * 4 <= (int)CTL_ZERO_BYTES, "ctl");

constexpr int RING_BYTES = 131072;
constexpr int LDS_HIST = 131072;
constexpr int LDS_MST = 147456;
constexpr int LDS_WT = 155648;
constexpr int LDS_BIAS = 139264;
constexpr int LDS_TBL = 156672;
constexpr int LDS_MISC = 158720;
constexpr int LDS_BYTES = 160 * 1024;

#define GAS __attribute__((address_space(1)))
#define LAS __attribute__((address_space(3)))
typedef unsigned short bf16_t;
typedef unsigned v4u __attribute__((ext_vector_type(4)));
typedef unsigned v2u __attribute__((ext_vector_type(2)));
typedef float f32x4 __attribute__((ext_vector_type(4)));
typedef float f32x2 __attribute__((ext_vector_type(2)));
typedef float f32x16 __attribute__((ext_vector_type(16)));
typedef short bf16x8 __attribute__((ext_vector_type(8)));
typedef GAS unsigned gu32;
#define RLX_AGENT __ATOMIC_RELAXED, __HIP_MEMORY_SCOPE_AGENT
#define LADD(p, v) __hip_atomic_fetch_add((p), (v), __ATOMIC_RELAXED, __HIP_MEMORY_SCOPE_WORKGROUP)
#define LDS_WAIT() asm volatile("s_waitcnt lgkmcnt(0)" ::: "memory")
#define VM_WAIT() asm volatile("s_waitcnt vmcnt(0)" ::: "memory")
__device__ __forceinline__ unsigned f2bf(float f) { unsigned u = __builtin_bit_cast(unsigned, f); return (u + 0x7fffu + ((u >> 16) & 1u)) >> 16; }
__device__ __forceinline__ unsigned pk2(float lo, float hi) { return f2bf(lo) | (f2bf(hi) << 16); }
__device__ __forceinline__ float bf2f(unsigned short b) { return __builtin_bit_cast(float, (unsigned)b << 16); }
__device__ __forceinline__ float wave_sum(float v) {
#pragma unroll
    for (int o = 1; o < 64; o <<= 1) v += __shfl_xor(v, o);
    return v;
}

namespace pg8 {
#define PG8_LAS __attribute__((address_space(3)))
constexpr int BM = 256, BK = 64, HALF = 128, HTB = HALF * BK * 2, STAGE_BYTES = 8 * HTB, NXCD = 8, WGM = 8;
__host__ __device__ __forceinline__ int lds_byte(int r, int c) { const int st = (r >> 4) * 2 + (c >> 5), rr = r & 15, cc = c & 31, ob = rr * 64 + cc * 2; return st * 1024 + (ob ^ (((ob >> 9) & 1) << 5)); }
__host__ __device__ __forceinline__ void stage_rc(int b, int& R, int& C) { const int st = b / 1024, sb = b % 1024, swz = sb ^ (((sb >> 9) & 1) << 5); R = (st >> 1) * 16 + swz / 64; C = (st & 1) * 32 + (swz % 64) / 2; }
__host__ __device__ __forceinline__ int perm32(int rho) { const int n = rho >> 4, i = rho & 15; return 8 * (i >> 2) + 4 * n + (i & 3); }
struct Unit { int pm, pn; };
struct Gemm { const bf16_t* A; const bf16_t* Bt; int K; const int* rowidx; };
struct StaticOrder {
    int nM, nN, nwg, G, c;
    __host__ __device__ void init(int M_, int N_, int G_, int c_) { nM = M_ / BM; nN = N_ / BM; nwg = nM * nN; G = G_; c = c_; }
    __host__ __device__ bool next(int i, Unit& u) const {
        const long L = (long)i * G + c; if (L >= nwg) return false;
        int wgid = (int)L; { const int q = nwg / NXCD, r = nwg % NXCD, xcd = wgid % NXCD, off = wgid / NXCD; wgid = (xcd < r ? xcd * (q + 1) : r * (q + 1) + (xcd - r) * q) + off; }
        const int nig = WGM * nN, gid = wgid / nig, fm = gid * WGM, gsz = (nM - fm) < WGM ? (nM - fm) : WGM;
        u.pm = fm + ((wgid % nig) % gsz); u.pn = (wgid % nig) / gsz; return true;
    }
};
__device__ __forceinline__ unsigned cvt_pk_bf16(float lo, float hi) { unsigned r; asm volatile("v_cvt_pk_bf16_f32 %0, %1, %2" : "=v"(r) : "v"(lo), "v"(hi)); return r; }

template <class Epi, class Sched, bool ALIGN_EPI, bool GATHER = false>
__device__ __forceinline__ void gemm_phase(PG8_LAS unsigned char* lds, const Gemm g, const Sched& S, const Epi& E) {
    const int tid = threadIdx.x, wid = __builtin_amdgcn_readfirstlane(tid >> 6), lane = tid & 63, wr = wid >> 2, wc = wid & 3, fr = lane & 15, fq = lane >> 4;
    const int K = g.K, nt = K / BK;
    int RA[2]; unsigned voffA[2], voffB[2];
#pragma unroll
    for (int i = 0; i < 2; ++i) { int R, C; stage_rc(tid * 16 + i * 8192, R, C); const int Rb = Epi::PERM ? ((R & ~31) + perm32(R & 31)) : R;
        RA[i] = R; voffA[i] = GATHER ? (unsigned)(C * 2) : (unsigned)(R * K + C) * 2u; voffB[i] = (unsigned)(Rb * K + C) * 2u; }
    const size_t kstep = (size_t)(BK * 2);
    const size_t hstep = (size_t)HALF * K * 2;
    const size_t tstep = 2 * hstep;
    const unsigned rowb = (unsigned)K * 2u;
    const unsigned ldsw = (unsigned)wid * 1024u;
    const int aoff = lds_byte(wr * 64 + fr, fq * 8), boff = lds_byte(wc * 32 + fr, fq * 8);
#define PG8_SA(b, h) (((b) * 2 + (h)) * HTB)
#define PG8_SB(b, h) ((4 + (b) * 2 + (h)) * HTB)
#define PG8_STAGE(bufoff, gbase, voff) do { _Pragma("unroll") for (int _i = 0; _i < 2; ++_i) \
        __builtin_amdgcn_global_load_lds((const unsigned*)((const char*)(gbase) + (voff)[_i]), (PG8_LAS unsigned*)(lds + (bufoff) + ldsw + _i * 8192), 16, 0, 0); } while (0)
#define PG8_STAGEA(bufoff, h, NX, kb) do { if constexpr (GATHER) { _Pragma("unroll") for (int _i = 0; _i < 2; ++_i) { const unsigned _o = (NX) ? an[h][_i] : ac[h][_i]; \
            __builtin_amdgcn_global_load_lds((const unsigned*)((const char*)g.A + (size_t)_o + (kb)), (PG8_LAS unsigned*)(lds + (bufoff) + ldsw + _i * 8192), 16, 0, 0); } } \
        else { const char* _b = ((NX) ? nA : cA) + (h) * hstep + (kb); PG8_STAGE(bufoff, _b, voffA); } } while (0)
#define PG8_LDA(dst, b, h) do { _Pragma("unroll") for (int m = 0; m < 4; ++m) _Pragma("unroll") for (int k = 0; k < 2; ++k) dst[m][k] = *(const PG8_LAS bf16x8*)(lds + PG8_SA(b, h) + aoff + m * 2048 + k * 1024); } while (0)
#define PG8_LDB(dst, b, h) do { _Pragma("unroll") for (int n = 0; n < 2; ++n) _Pragma("unroll") for (int k = 0; k < 2; ++k) dst[n][k] = *(const PG8_LAS bf16x8*)(lds + PG8_SB(b, h) + boff + n * 2048 + k * 1024); } while (0)
#define PG8_MMA(ai, bj, At, Bt) do { __builtin_amdgcn_s_setprio(1); _Pragma("unroll") for (int m = 0; m < 4; ++m) _Pragma("unroll") for (int n = 0; n < 2; ++n) _Pragma("unroll") for (int k = 0; k < 2; ++k) \
        acc[ai][bj][m][n] = __builtin_amdgcn_mfma_f32_16x16x32_bf16(Bt[n][k], At[m][k], acc[ai][bj][m][n], 0, 0, 0); __builtin_amdgcn_s_setprio(0); } while (0)
#define PG8_WAIT_V(n) asm volatile("s_waitcnt vmcnt(" #n ")" ::: "memory")
#define PG8_WAIT_L(n) asm volatile("s_waitcnt lgkmcnt(" #n ")" ::: "memory")
#define PG8_BAR __builtin_amdgcn_s_barrier()
#define PG8_SCHED __builtin_amdgcn_sched_barrier(0)
#define PG8_AROWS(dst, un) do { _Pragma("unroll") for (int _h = 0; _h < 2; ++_h) _Pragma("unroll") for (int _i = 0; _i < 2; ++_i) { \
        const int _r = (un).pm * BM + _h * HALF + RA[_i]; dst[_h][_i] = (unsigned)g.rowidx[_r] * rowb + voffA[_i]; } } while (0)
    Unit cur, nxt; int ui = 0;
    if (!S.next(0, cur)) return;
    f32x4 acc[2][2][4][2];
#pragma unroll
    for (int a = 0; a < 2; ++a)
#pragma unroll
        for (int b = 0; b < 2; ++b)
#pragma unroll
            for (int m = 0; m < 4; ++m)
#pragma unroll
                for (int n = 0; n < 2; ++n) acc[a][b][m][n] = (f32x4){0.f, 0.f, 0.f, 0.f};
    bf16x8 At[4][2], B0[2][2], B1[2][2];
    unsigned ac[2][2], an[2][2];
    if constexpr (GATHER) { PG8_AROWS(ac, cur); }
    const char* cA = (const char*)g.A + (size_t)cur.pm * tstep; const char* nA = cA;
    const char* cB = (const char*)g.Bt + (size_t)cur.pn * tstep;
    {
        PG8_STAGE(PG8_SB(0, 0), cB, voffB); PG8_STAGE(PG8_SB(0, 1), cB + hstep, voffB); PG8_STAGEA(PG8_SA(0, 0), 0, false, 0); PG8_STAGEA(PG8_SA(0, 1), 1, false, 0);
        if (wr == 1) PG8_BAR;
        PG8_WAIT_V(2); PG8_BAR;
        PG8_STAGE(PG8_SB(1, 0), cB + kstep, voffB); PG8_STAGEA(PG8_SA(1, 0), 0, false, kstep); PG8_STAGE(PG8_SB(1, 1), cB + hstep + kstep, voffB);
        PG8_WAIT_V(6); PG8_BAR;
    }
    for (;;) {
        const bool has_next = S.next(ui + 1, nxt);
        if constexpr (GATHER) { if (has_next) { PG8_AROWS(an, nxt); } else {
#pragma unroll
            for (int h = 0; h < 2; ++h)
#pragma unroll
                for (int i = 0; i < 2; ++i) an[h][i] = ac[h][i]; } }
        nA = has_next ? (const char*)g.A + (size_t)nxt.pm * tstep : cA;
        const char* nB = has_next ? (const char*)g.Bt + (size_t)nxt.pn * tstep : cB;
        for (int t = 0; t < nt; t += 2) {
            const bool last = (t == nt - 2);
            const size_t kb1 = (size_t)(t + 1) * kstep;
            const size_t kb2 = last ? 0 : (size_t)(t + 2) * kstep, kb3 = kb2 + kstep;
            const char* b2 = last ? nB : cB + (size_t)(t + 2) * kstep; const char* b3 = b2 + kstep;
            PG8_LDB(B0, 0, 0); PG8_LDB(B1, 0, 1); PG8_SCHED; PG8_LDA(At, 0, 0); PG8_STAGEA(PG8_SA(1, 1), 1, false, kb1);
            PG8_WAIT_V(8); PG8_WAIT_L(0); PG8_BAR; PG8_MMA(0, 0, At, B0); PG8_MMA(0, 1, At, B1); PG8_BAR; PG8_SCHED;
            PG8_LDA(At, 0, 1); PG8_STAGE(PG8_SB(0, 0), b2, voffB); PG8_STAGE(PG8_SB(0, 1), b2 + hstep, voffB); PG8_STAGEA(PG8_SA(0, 0), 0, last, kb2);
            PG8_WAIT_V(8); PG8_WAIT_L(0); PG8_BAR; PG8_MMA(1, 0, At, B0); PG8_MMA(1, 1, At, B1); PG8_BAR; PG8_SCHED;
            PG8_LDB(B0, 1, 0); PG8_LDB(B1, 1, 1); PG8_SCHED; PG8_LDA(At, 1, 0); PG8_STAGEA(PG8_SA(0, 1), 1, last, kb2);
            PG8_WAIT_V(8); PG8_WAIT_L(0); PG8_BAR; PG8_MMA(0, 0, At, B0); PG8_MMA(0, 1, At, B1); PG8_BAR; PG8_SCHED;
            PG8_LDA(At, 1, 1); PG8_STAGE(PG8_SB(1, 0), b3, voffB); PG8_STAGE(PG8_SB(1, 1), b3 + hstep, voffB); PG8_STAGEA(PG8_SA(1, 0), 0, last, kb3);
            PG8_WAIT_V(8); PG8_WAIT_L(0); PG8_BAR; PG8_MMA(1, 0, At, B0); PG8_MMA(1, 1, At, B1); PG8_BAR; PG8_SCHED;
        }
        if constexpr (ALIGN_EPI) { if (wr == 0) PG8_BAR; }
        E(acc, cur, wr, wc, fr, fq);
        if (!has_next) break;
#pragma unroll
        for (int a = 0; a < 2; ++a)
#pragma unroll
            for (int b = 0; b < 2; ++b)
#pragma unroll
                for (int m = 0; m < 4; ++m)
#pragma unroll
                    for (int n = 0; n < 2; ++n) acc[a][b][m][n] = (f32x4){0.f, 0.f, 0.f, 0.f};
        cur = nxt; cA = nA; cB = nB; ++ui;
        if constexpr (GATHER) {
#pragma unroll
            for (int h = 0; h < 2; ++h)
#pragma unroll
                for (int i = 0; i < 2; ++i) ac[h][i] = an[h][i]; }
        if constexpr (ALIGN_EPI) { if (wr == 1) PG8_BAR; }
    }
    PG8_WAIT_V(0);
    if constexpr (!ALIGN_EPI) { if (wr == 0) PG8_BAR; }
    PG8_BAR;
#undef PG8_SA
#undef PG8_SB
#undef PG8_STAGE
#undef PG8_STAGEA
#undef PG8_LDA
#undef PG8_LDB
#undef PG8_MMA
#undef PG8_WAIT_V
#undef PG8_WAIT_L
#undef PG8_BAR
#undef PG8_SCHED
#undef PG8_AROWS
}

struct EpiInProj {
    static constexpr bool PERM = true;
    bf16_t* Q; bf16_t* IK; float* IW;
    __device__ __forceinline__ void operator()(const f32x4 (&acc)[2][2][4][2], const Unit& u, int wr, int wc, int fr, int fq) const {
        const int row0 = u.pm * BM + wr * 64 + fr;
        if (u.pn < 10) {
            const int t = u.pn >> 1; bf16_t* base = Q + (size_t)t * ((size_t)M * AW); const float sc = (t == 0) ? QSCALE : 1.f;
            const int col0 = (u.pn & 1) * 256 + wc * 32 + 8 * fq;
#pragma unroll
            for (int ai = 0; ai < 2; ++ai)
#pragma unroll
                for (int m = 0; m < 4; ++m) { bf16_t* rowp = base + (size_t)(row0 + ai * HALF + m * 16) * AW + col0;
#pragma unroll
                    for (int bj = 0; bj < 2; ++bj) { const f32x4 v0 = acc[ai][bj][m][0] * sc, v1 = acc[ai][bj][m][1] * sc;
                        v4u w; w.x = cvt_pk_bf16(v0[0], v0[1]); w.y = cvt_pk_bf16(v0[2], v0[3]); w.z = cvt_pk_bf16(v1[0], v1[1]); w.w = cvt_pk_bf16(v1[2], v1[3]);
                        *(v4u*)(rowp + bj * HALF) = w; } }
        } else {
            if (wc < 2) {
#pragma unroll
                for (int ai = 0; ai < 2; ++ai)
#pragma unroll
                    for (int m = 0; m < 4; ++m) { const f32x4 v0 = acc[ai][0][m][0], v1 = acc[ai][0][m][1];
                        v4u w; w.x = cvt_pk_bf16(v0[0], v0[1]); w.y = cvt_pk_bf16(v0[2], v0[3]); w.z = cvt_pk_bf16(v1[0], v1[1]); w.w = cvt_pk_bf16(v1[2], v1[3]);
                        *(v4u*)(IK + (size_t)(row0 + ai * HALF + m * 16) * 64 + wc * 32 + 8 * fq) = w; }
            } else if (wc == 2 && fq == 0) {
#pragma unroll
                for (int ai = 0; ai < 2; ++ai)
#pragma unroll
                    for (int m = 0; m < 4; ++m) { float* p = IW + (size_t)(row0 + ai * HALF + m * 16) * 8;
                        *(f32x4*)p = acc[ai][0][m][0]; *(f32x4*)(p + 4) = acc[ai][0][m][1]; }
            }
        }
    }
};
struct EpiBf16Plain {
    static constexpr bool PERM = true;
    bf16_t* O; int ldc; int coloff;
    __device__ __forceinline__ void operator()(const f32x4 (&acc)[2][2][4][2], const Unit& u, int wr, int wc, int fr, int fq) const {
        const int row0 = u.pm * BM + wr * 64 + fr, col0 = coloff + u.pn * BM + wc * 32 + 8 * fq;
#pragma unroll
        for (int ai = 0; ai < 2; ++ai)
#pragma unroll
            for (int m = 0; m < 4; ++m) { bf16_t* rowp = O + (size_t)(row0 + ai * HALF + m * 16) * ldc + col0;
#pragma unroll
                for (int bj = 0; bj < 2; ++bj) { const f32x4 v0 = acc[ai][bj][m][0], v1 = acc[ai][bj][m][1];
                    v4u w; w.x = cvt_pk_bf16(v0[0], v0[1]); w.y = cvt_pk_bf16(v0[2], v0[3]); w.z = cvt_pk_bf16(v1[0], v1[1]); w.w = cvt_pk_bf16(v1[2], v1[3]);
                    *(v4u*)(rowp + bj * HALF) = w; } }
    }
};
struct EpiF32 {
    static constexpr bool PERM = false;
    float* O; int ldc;
    __device__ __forceinline__ void operator()(const f32x4 (&acc)[2][2][4][2], const Unit& u, int wr, int wc, int fr, int fq) const {
        const int row0 = u.pm * BM + wr * 64 + fr, col0 = u.pn * BM + wc * 32 + 4 * fq;
#pragma unroll
        for (int ai = 0; ai < 2; ++ai)
#pragma unroll
            for (int m = 0; m < 4; ++m) { float* rowp = O + (size_t)(row0 + ai * HALF + m * 16) * ldc + col0;
#pragma unroll
                for (int bj = 0; bj < 2; ++bj)
#pragma unroll
                    for (int n = 0; n < 2; ++n) *(f32x4*)(rowp + bj * HALF + n * 16) = acc[ai][bj][m][n]; }
    }
};
struct EpiGateUp {
    static constexpr bool PERM = true;
    bf16_t* ACT;
    __device__ __forceinline__ void operator()(const f32x4 (&acc)[2][2][4][2], const Unit& u, int wr, int wc, int fr, int fq) const {
        const int row0 = u.pm * BM + wr * 64 + fr, col0 = (u.pn & 1) * 128 + wc * 32 + 8 * fq;
#pragma unroll
        for (int ai = 0; ai < 2; ++ai)
#pragma unroll
            for (int m = 0; m < 4; ++m) { float o[8];
#pragma unroll
                for (int n = 0; n < 2; ++n)
#pragma unroll
                    for (int e = 0; e < 4; ++e) { const float gt = acc[ai][0][m][n][e], up = acc[ai][1][m][n][e];
                        const float sg = gt * __builtin_amdgcn_rcpf(1.f + __builtin_amdgcn_exp2f(-gt * LOG2E)); o[n * 4 + e] = sg * up; }
                v4u w; w.x = cvt_pk_bf16(o[0], o[1]); w.y = cvt_pk_bf16(o[2], o[3]); w.z = cvt_pk_bf16(o[4], o[5]); w.w = cvt_pk_bf16(o[6], o[7]);
                *(v4u*)(ACT + (size_t)(row0 + ai * HALF + m * 16) * DEXP + col0) = w; }
    }
};
struct EpiDown {
    static constexpr bool PERM = true;
    bf16_t* YS; const float* wrow;
    __device__ __forceinline__ void operator()(const f32x4 (&acc)[2][2][4][2], const Unit& u, int wr, int wc, int fr, int fq) const {
        const int row0 = u.pm * BM + wr * 64 + fr, col0 = (u.pn & 3) * 256 + wc * 32 + 8 * fq;
#pragma unroll
        for (int ai = 0; ai < 2; ++ai)
#pragma unroll
            for (int m = 0; m < 4; ++m) { const int row = row0 + ai * HALF + m * 16; const float sc = wrow[row]; bf16_t* rowp = YS + (size_t)row * DM + col0;
#pragma unroll
                for (int bj = 0; bj < 2; ++bj) { const f32x4 v0 = acc[ai][bj][m][0] * sc, v1 = acc[ai][bj][m][1] * sc;
                    v4u w; w.x = cvt_pk_bf16(v0[0], v0[1]); w.y = cvt_pk_bf16(v0[2], v0[3]); w.z = cvt_pk_bf16(v1[0], v1[1]); w.w = cvt_pk_bf16(v1[2], v1[3]);
                    *(v4u*)(rowp + bj * HALF) = w; } }
    }
};
template <int NC> struct MoeOrder {
    const LAS int* tile_e; int RT, G, c;
    __device__ __forceinline__ bool next(int i, Unit& u) const {
        const int L = i * G + c; if (L >= RT * NC) return false;
        const int rt = L / NC, ct = L % NC; u.pm = rt; u.pn = tile_e[rt] * NC + ct; return true;
    }
};
}

namespace attn_body {
using bf16 = __hip_bfloat16;
using s16x4 = __attribute__((ext_vector_type(4))) short;
using u32x4 = __attribute__((ext_vector_type(4))) unsigned;
constexpr int NHEAD = 8, D = 64, KP = NHEAD * D  , OP = 1024  ;
constexpr int NW = 8, QBLK = 32, QB = QBLK * NW, KVBLK = 64, NQB = SEQ / QB;
__device__ __forceinline__ int crow(int r, int hi) { return (r & 3) + 8 * (r >> 2) + 4 * hi; }
#define SBAR() __builtin_amdgcn_sched_barrier(0)
constexpr int NSLOT = 3, SLOTB = 8192;
constexpr int LDS_K = 0, LDS_V = NSLOT * SLOTB, LDS_WS = 2 * NSLOT * SLOTB, LDS_OST = LDS_WS + NW * 64 * 4, ATT_LDS_BYTES = LDS_OST + NW * 4096;
__device__ __forceinline__ void glds16(const void* gsrc, unsigned lds_dst) { unsigned keep;
    asm volatile("s_mov_b32 %0, m0\n\ts_mov_b32 m0, %2\n\ts_nop 0\n\tglobal_load_lds_dwordx4 %1, off\n\ts_mov_b32 m0, %0" : "=&s"(keep) : "v"(gsrc), "s"(lds_dst) : "memory"); }
__device__ __forceinline__ float max3f(float a, float b, float c) { float r; asm("v_max3_f32 %0, %1, %2, %3" : "=v"(r) : "v"(a), "v"(b), "v"(c)); return r; }
__device__ __forceinline__ float max2f(float a, float b) { float r; asm("v_max_f32_e32 %0, %1, %2" : "=v"(r) : "v"(a), "v"(b)); return r; }
__device__ __forceinline__ float fadd_s(float a, float b) { float r; asm("v_add_f32_e32 %0, %1, %2" : "=v"(r) : "v"(a), "v"(b)); return r; }
__device__ __forceinline__ float fsub_s(float a, float b) { float r; asm("v_sub_f32_e32 %0, %1, %2" : "=v"(r) : "v"(a), "v"(b)); return r; }
typedef float f32x2_t __attribute__((ext_vector_type(2))); typedef __bf16 bf16x2_t __attribute__((ext_vector_type(2)));
__device__ __forceinline__ unsigned cvtpk_s(float lo, float hi) { f32x2_t v = {lo, hi}; bf16x2_t b = __builtin_convertvector(v, bf16x2_t); return __builtin_bit_cast(unsigned, b); }
#define WAIT_BAR(N) asm volatile("s_waitcnt vmcnt(" #N ") lgkmcnt(0)\n\ts_barrier" ::: "memory")
__device__ __forceinline__ void qkt(f32x16& p0, f32x16& p1, const char* Kslot, const bf16x8* qr, int r32, int hi) {
    const char* kb = Kslot + hi * 1024 + r32 * 16;
#pragma unroll
    for (int d0 = 0; d0 < 4; ++d0) {
        const bf16x8 b0 = *reinterpret_cast<const bf16x8*>(kb + d0 * 2048);
        const bf16x8 b1 = *reinterpret_cast<const bf16x8*>(kb + d0 * 2048 + 512);
        if (d0 == 0) { p0 = __builtin_amdgcn_mfma_f32_32x32x16_bf16(b0, qr[0], f32x16{}, 0, 0, 0); p1 = __builtin_amdgcn_mfma_f32_32x32x16_bf16(b1, qr[0], f32x16{}, 0, 0, 0); }
        else { p0 = __builtin_amdgcn_mfma_f32_32x32x16_bf16(b0, qr[d0], p0, 0, 0, 0); p1 = __builtin_amdgcn_mfma_f32_32x32x16_bf16(b1, qr[d0], p1, 0, 0, 0); } }
}
typedef __attribute__((address_space(3))) const char* lds_cptr;
typedef short v4i16_t __attribute__((ext_vector_type(4)));
__device__ __forceinline__ void kload8(bf16x8* kf, lds_cptr kp) {
    kf[0] = *(const __attribute__((address_space(3))) bf16x8*)(kp);        kf[1] = *(const __attribute__((address_space(3))) bf16x8*)(kp + 512);
    kf[2] = *(const __attribute__((address_space(3))) bf16x8*)(kp + 2048); kf[3] = *(const __attribute__((address_space(3))) bf16x8*)(kp + 2560);
    kf[4] = *(const __attribute__((address_space(3))) bf16x8*)(kp + 4096); kf[5] = *(const __attribute__((address_space(3))) bf16x8*)(kp + 4608);
    kf[6] = *(const __attribute__((address_space(3))) bf16x8*)(kp + 6144); kf[7] = *(const __attribute__((address_space(3))) bf16x8*)(kp + 6656);
}
__device__ __forceinline__ void kload2(bf16x8* kf, lds_cptr kp, int j) { kf[2 * j] = *(const __attribute__((address_space(3))) bf16x8*)(kp + j * 2048); kf[2 * j + 1] = *(const __attribute__((address_space(3))) bf16x8*)(kp + j * 2048 + 512); }
__device__ __forceinline__ s16x4 vtr(lds_cptr p) { return __builtin_bit_cast(s16x4, __builtin_amdgcn_ds_read_tr16_b64_v4i16((__attribute__((address_space(3))) v4i16_t*)p)); }
__device__ __forceinline__ float rowmax(const f32x16& p0, const f32x16& p1) {
    float a = max3f(p0[0], p0[1], p1[0]), b = max3f(p0[2], p0[3], p1[1]); a = max3f(a, p1[2], p1[3]);
#pragma unroll
    for (int r = 4; r < 16; r += 4) { a = max3f(a, p0[r], p0[r + 1]); b = max3f(b, p0[r + 2], p0[r + 3]); a = max3f(a, p1[r], p1[r + 1]); b = max3f(b, p1[r + 2], p1[r + 3]); }
    const float m = max2f(a, b);
    auto rr = __builtin_amdgcn_permlane32_swap(__float_as_uint(m), __float_as_uint(m), false, false);
    return max2f(__uint_as_float(rr[0]), __uint_as_float(rr[1]));
}
__device__ __forceinline__ void pv(f32x16* o, int vb, bf16x8 pa0, bf16x8 pa1, bf16x8 pa2, bf16x8 pa3) {
#pragma unroll
    for (int d0 = 0; d0 < 2; ++d0) { s16x4 lo[4], hi[4];
#pragma unroll
        for (int ks = 0; ks < 4; ++ks) {
            asm volatile("ds_read_b64_tr_b16 %0,%1 offset:%c2" : "=&v"(lo[ks]) : "v"(vb), "i"(d0 * 4096 + ks * 1024) : "memory");
            asm volatile("ds_read_b64_tr_b16 %0,%1 offset:%c2" : "=&v"(hi[ks]) : "v"(vb), "i"(d0 * 4096 + ks * 1024 + 512) : "memory"); }
        asm volatile("s_waitcnt lgkmcnt(0)" ::: "memory"); SBAR();
#define PK(k) (bf16x8){lo[k][0], lo[k][1], lo[k][2], lo[k][3], hi[k][0], hi[k][1], hi[k][2], hi[k][3]}
        o[d0] = __builtin_amdgcn_mfma_f32_32x32x16_bf16(pa0, PK(0), o[d0], 0, 0, 0);
        o[d0] = __builtin_amdgcn_mfma_f32_32x32x16_bf16(pa1, PK(1), o[d0], 0, 0, 0);
        o[d0] = __builtin_amdgcn_mfma_f32_32x32x16_bf16(pa2, PK(2), o[d0], 0, 0, 0);
        o[d0] = __builtin_amdgcn_mfma_f32_32x32x16_bf16(pa3, PK(3), o[d0], 0, 0, 0);
#undef PK
    }
}
__device__ __forceinline__ float pmask(float p, unsigned mw, int r) { const int b = (r & 3) + 8 * (r >> 2); return __uint_as_float(__float_as_uint(p) & (unsigned)__builtin_amdgcn_sbfe((int)mw, b, 1)); }
__device__ __forceinline__ void xbias(f32x16& p0, f32x16& p1, const LAS float* tb) {
#pragma unroll
    for (int g = 0; g < 4; ++g) {
#pragma unroll
        for (int r = 4 * g; r < 4 * g + 4; ++r) { const int b = (r & 3) + 8 * (r >> 2); p0[r] += tb[b]; p1[r] += tb[b + 32]; }
        asm volatile("" : "+v"(p0), "+v"(p1) :: "memory"); }
}

template <int THRL> __device__ __forceinline__ void attn_unit(int b, int h, int qb, const bf16* Q, const bf16* __restrict__ K, const bf16* __restrict__ V, bf16* O, const unsigned* MASKQ, const LAS float* btab, char* shm) {
    const int tid = threadIdx.x, lane = tid & 63, r32 = lane & 31, hi = lane >> 5; const int wid = __builtin_amdgcn_readfirstlane(tid >> 6);
    const long rowbase = (long)b * SEQ; const int q0 = qb * QB;
    const bf16* Qw = Q + (rowbase + q0 + wid * QBLK) * KP + h * D;
    const bf16 *Kh = K + rowbase * KP + h * D, *Vh = V + rowbase * KP + h * D;
    const unsigned lds0 = (unsigned)(uintptr_t)shm;
    float* wsf = (float*)(shm + LDS_WS) + wid * 64;
    const bf16* ksrc = Kh + (long)lane * KP + wid * 8;
    const bf16* vsrc = Vh + (long)(16 * (wid & 3) + (lane >> 2)) * KP + (wid >> 2) * 32 + (lane & 3) * 8;
    const unsigned kdst = lds0 + LDS_K + wid * 1024, vdst = lds0 + LDS_V + wid * 1024;
#define DMA_K(t, slot) glds16(ksrc + (long)(t) * KVBLK * KP, (unsigned)__builtin_amdgcn_readfirstlane(kdst + (slot)))
#define DMA_V(t, slot) glds16(vsrc + (long)(t) * KVBLK * KP, (unsigned)__builtin_amdgcn_readfirstlane(vdst + (slot)))
    const int vb0 = (int)(lds0 + LDS_V) + ((lane >> 4) & 1) * 32 + (lane & 3) * 8 + (4 * hi + ((lane & 15) >> 2)) * 64;
    const char* Kbase = shm + LDS_K; bf16x8 kf[8];
    const lds_cptr shm3 = (lds_cptr)shm; const lds_cptr kp0 = shm3 + LDS_K + hi * 1024 + r32 * 16; const lds_cptr vp0 = shm3 + LDS_V + ((lane >> 4) & 1) * 32 + (lane & 3) * 8 + (4 * hi + ((lane & 15) >> 2)) * 64;
    const int NT = (q0 + QB) / KVBLK;
    const int qrel = wid * QBLK + r32;
    const unsigned char* mbase = (const unsigned char*)(MASKQ + (size_t)(rowbase + q0) * 128); const unsigned moff = (unsigned)qrel * 512u;
#define LDM(t) (*(const v2u*)(mbase + (size_t)(8 * (t)) + moff))
    v2u mwc = LDM(0); mwc.x >>= 4 * hi; mwc.y >>= 4 * hi;
    DMA_K(0, 0); DMA_V(0, 0); DMA_K(1, SLOTB);
    bf16x8 qr[4];
#pragma unroll
    for (int d0 = 0; d0 < 4; ++d0) qr[d0] = *reinterpret_cast<const bf16x8*>(&Qw[(long)r32 * KP + d0 * 16 + hi * 8]);
    float mhat = 0.f, l_reg = 0.f; f32x16 o[2]; o[0] = f32x16{}; o[1] = f32x16{};
    const int bidx0 = 4 * hi - (q0 + qrel) + 448;
#define XMB(P0, P1, t) do { if ((t) >= NT - 7) xbias(P0, P1, btab + (bidx0 + 64 * (t))); } while (0)
    bool resc = false;
#define START(P0, P1) do { const float rm = rowmax(P0, P1); resc = false; \
    { const float dl = rm; mhat = fadd_s(mhat, dl); \
      _Pragma("unroll") for (int r = 0; r < 16; ++r) { P0[r] = fsub_s(P0[r], dl); P1[r] = fsub_s(P1[r], dl); } } \
    _Pragma("unroll") for (int r = 0; r < 16; ++r) P0[r] = pmask(__builtin_amdgcn_exp2f(P0[r]), mwc.x, r); } while (0)
#define RESC() do { if (resc) { asm volatile("s_waitcnt lgkmcnt(0)" ::: "memory"); \
      _Pragma("unroll") for (int d_ = 0; d_ < 2; ++d_) _Pragma("unroll") for (int r = 0; r < 16; ++r) o[d_][r] *= wsf[crow(r, hi)]; } } while (0)
    f32x16 pA0, pA1, pB0, pB1;
    int sl_prev = 0, sl_cur = 0, sl_next = SLOTB;
#define ROT() do { sl_prev = sl_cur; sl_cur = sl_next; sl_next = (sl_next == (NSLOT - 1) * SLOTB) ? 0 : sl_next + SLOTB; } while (0)
    DMA_K(2, 2 * SLOTB);
    WAIT_BAR(3);
    qkt(pA0, pA1, Kbase, qr, r32, hi); asm volatile("s_nop 15\n\ts_nop 7" : "+v"(pA0), "+v"(pA1)); XMB(pA0, pA1, 0);
    START(pA0, pA1);
    _Pragma("unroll") for (int r = 0; r < 16; ++r) pA1[r] = pmask(__builtin_amdgcn_exp2f(pA1[r]), mwc.y, r);

    WAIT_BAR(0);
    DMA_K(3, 0); DMA_V(1, SLOTB);
    ROT();
    kload8(kf, kp0 + sl_cur);
    WAIT_BAR(2);
    s16x4 vlo[8], vhi[8]; u32x4 pw0, pw1, pw2, pw3;
#define PKW(P, B) cvtpk_s(P[B], P[B + 1])
#define PAF(k) __builtin_bit_cast(bf16x8, pw##k)
#define VFR(i) (bf16x8){vlo[i][0], vlo[i][1], vlo[i][2], vlo[i][3], vhi[i][0], vhi[i][1], vhi[i][2], vhi[i][3]}
#define PIN(x) asm volatile("" : "+v"(x))
#define MX3(a, b, c) __builtin_fmaxf(__builtin_fmaxf((a), (b)), (c))
#define GAPA(MF, A0, A1, A2, A3, W0, W1, PW) do { MF; sacc += A0; sacc += A1; sacc += A2; sacc += A3; PIN(sacc); W0; W1; PIN(PW); SBAR(); } while (0)
#define EX(v) __builtin_amdgcn_exp2f(v)
#define GAPB(MF, X, B, MW) do { MF; X[B] = pmask(EX(X[B] - mhat), MW, B); X[B + 1] = pmask(EX(X[B + 1] - mhat), MW, B + 1); X[B + 2] = pmask(EX(X[B + 2] - mhat), MW, B + 2); X[B + 3] = pmask(EX(X[B + 3] - mhat), MW, B + 3); PIN(X); SBAR(); } while (0)
#define VRD(i) do { vlo[i] = vtr(vp_ + (((i) >> 2) * 4096 + ((i) & 3) * 1024)); vhi[i] = vtr(vp_ + (((i) >> 2) * 4096 + ((i) & 3) * 1024 + 512)); } while (0)
#define KRD(G, j) do { if (G) { kload2(kf, kp0 + sl_next, j); SBAR(); } } while (0)
#define STEP(C0, C1, P0, P1, t, GK, GV, GL) do { SBAR(); \
    const lds_cptr vp_ = vp0 + sl_prev; \
    mwc = LDM(t); \
    VRD(0); SBAR(); float sacc = (P0[0] + P0[1]); \
    GAPA(C0 = __builtin_amdgcn_mfma_f32_32x32x16_bf16(kf[0], qr[0], f32x16{}, 0, 0, 0), P0[2], P0[3], P0[4], P0[5],     pw0[0] = PKW(P0, 0), pw0[1] = PKW(P0, 2), pw0); \
    VRD(4); SBAR(); GAPA(C1 = __builtin_amdgcn_mfma_f32_32x32x16_bf16(kf[1], qr[0], f32x16{}, 0, 0, 0), P0[6], P0[7], P0[8], P0[9],     pw0[2] = PKW(P0, 4), pw0[3] = PKW(P0, 6), pw0); \
    VRD(1); SBAR(); GAPA(C0 = __builtin_amdgcn_mfma_f32_32x32x16_bf16(kf[2], qr[1], C0, 0, 0, 0),   P0[10], P0[11], P0[12], P0[13], pw1[0] = PKW(P0, 8), pw1[1] = PKW(P0, 10), pw1); \
    VRD(5); SBAR(); GAPA(C1 = __builtin_amdgcn_mfma_f32_32x32x16_bf16(kf[3], qr[1], C1, 0, 0, 0),   P0[14], P0[15], P1[0], P1[1],   pw1[2] = PKW(P0, 12), pw1[3] = PKW(P0, 14), pw1); \
    VRD(2); SBAR(); GAPA(C0 = __builtin_amdgcn_mfma_f32_32x32x16_bf16(kf[4], qr[2], C0, 0, 0, 0),   P1[2], P1[3], P1[4], P1[5],     pw2[0] = PKW(P1, 0), pw2[1] = PKW(P1, 2), pw2); \
    VRD(6); SBAR(); GAPA(C1 = __builtin_amdgcn_mfma_f32_32x32x16_bf16(kf[5], qr[2], C1, 0, 0, 0),   P1[6], P1[7], P1[8], P1[9],     pw2[2] = PKW(P1, 4), pw2[3] = PKW(P1, 6), pw2); \
    VRD(3); SBAR(); GAPA(C0 = __builtin_amdgcn_mfma_f32_32x32x16_bf16(kf[6], qr[3], C0, 0, 0, 0),   P1[10], P1[11], P1[12], P1[13], pw3[0] = PKW(P1, 8), pw3[1] = PKW(P1, 10), pw3); \
    VRD(7); SBAR(); GAPA(C1 = __builtin_amdgcn_mfma_f32_32x32x16_bf16(kf[7], qr[3], C1, 0, 0, 0),   P1[14], P1[15], 0.f, 0.f,       pw3[2] = PKW(P1, 12), pw3[3] = PKW(P1, 14), pw3); \
    l_reg += sacc; \
    if (GK) { DMA_K((t) + 3, sl_cur); } if (GV) { DMA_V((t) + 1, sl_next); } \
    XMASKB(C0, C1, t); mwc.x >>= 4 * hi; mwc.y >>= 4 * hi; \
    { float a = MX3(C0[0], C0[1], C1[0]), b = MX3(C0[2], C0[3], C1[1]); a = MX3(a, C1[2], C1[3]); \
      _Pragma("unroll") for (int r = 4; r < 16; r += 4) { a = MX3(a, C0[r], C0[r + 1]); b = MX3(b, C0[r + 2], C0[r + 3]); a = MX3(a, C1[r], C1[r + 1]); b = MX3(b, C1[r + 2], C1[r + 3]); } \
      float rm = __builtin_fmaxf(a, b); { auto rr = __builtin_amdgcn_permlane32_swap(__float_as_uint(rm), __float_as_uint(rm), false, false); rm = __builtin_fmaxf(__uint_as_float(rr[0]), __uint_as_float(rr[1])); } \
      resc = false; rm -= mhat; \
      if (__builtin_expect(__any(rm > (float)THRL), 0)) { const float dl = __builtin_fmaxf(rm, 0.f); mhat += dl; \
        const float f = __builtin_amdgcn_exp2f(-dl); l_reg *= f; if (hi == 0) wsf[r32] = f; resc = true; } } \
    SBAR(); \
    GAPB(o[0] = __builtin_amdgcn_mfma_f32_32x32x16_bf16(PAF(0), VFR(0), o[0], 0, 0, 0), C0, 0, mwc.x); \
    GAPB(o[1] = __builtin_amdgcn_mfma_f32_32x32x16_bf16(PAF(0), VFR(4), o[1], 0, 0, 0), C0, 4, mwc.x); \
    KRD(GL, 0); GAPB(o[0] = __builtin_amdgcn_mfma_f32_32x32x16_bf16(PAF(1), VFR(1), o[0], 0, 0, 0), C0, 8, mwc.x); \
    KRD(GL, 1); GAPB(o[1] = __builtin_amdgcn_mfma_f32_32x32x16_bf16(PAF(1), VFR(5), o[1], 0, 0, 0), C0, 12, mwc.x); \
    KRD(GL, 2); GAPB(o[0] = __builtin_amdgcn_mfma_f32_32x32x16_bf16(PAF(2), VFR(2), o[0], 0, 0, 0), C1, 0, mwc.y); \
    KRD(GL, 3); GAPB(o[1] = __builtin_amdgcn_mfma_f32_32x32x16_bf16(PAF(2), VFR(6), o[1], 0, 0, 0), C1, 4, mwc.y); \
    GAPB(o[0] = __builtin_amdgcn_mfma_f32_32x32x16_bf16(PAF(3), VFR(3), o[0], 0, 0, 0), C1, 8, mwc.y); \
    GAPB(o[1] = __builtin_amdgcn_mfma_f32_32x32x16_bf16(PAF(3), VFR(7), o[1], 0, 0, 0), C1, 12, mwc.y); \
    } while (0)
    int t = 1;
#define XMASKB(P0, P1, t) do { } while (0)
    for (; t + 7 < NT; t += 2) {
        STEP(pB0, pB1, pA0, pA1, t, true, true, true);     WAIT_BAR(2); RESC(); ROT();
        STEP(pA0, pA1, pB0, pB1, t + 1, true, true, true); WAIT_BAR(2); RESC(); ROT();
    }
#undef XMASKB
#define XMASKB(P0, P1, t) XMB(P0, P1, t)
#define ENDW(tt) do { if ((tt) + 3 < NT) { WAIT_BAR(2); } else if ((tt) + 2 < NT) { WAIT_BAR(1); } else { WAIT_BAR(0); } } while (0)
    for (; t + 1 < NT; t += 2) {
        STEP(pB0, pB1, pA0, pA1, t, (t + 3 < NT), (t + 1 < NT), (t + 1 < NT));         ENDW(t);     RESC(); ROT();
        STEP(pA0, pA1, pB0, pB1, t + 1, (t + 4 < NT), (t + 2 < NT), (t + 2 < NT));     ENDW(t + 1); RESC(); ROT();
    }
    STEP(pB0, pB1, pA0, pA1, NT - 1, false, false, false); RESC();
    { float sacc = pB0[0] + pB0[1]; _Pragma("unroll") for (int r = 2; r < 16; ++r) sacc += pB0[r]; _Pragma("unroll") for (int r = 0; r < 16; ++r) sacc += pB1[r]; l_reg += sacc;
      pw0 = (u32x4){PKW(pB0, 0), PKW(pB0, 2), PKW(pB0, 4), PKW(pB0, 6)}; pw1 = (u32x4){PKW(pB0, 8), PKW(pB0, 10), PKW(pB0, 12), PKW(pB0, 14)}; pw2 = (u32x4){PKW(pB1, 0), PKW(pB1, 2), PKW(pB1, 4), PKW(pB1, 6)}; pw3 = (u32x4){PKW(pB1, 8), PKW(pB1, 10), PKW(pB1, 12), PKW(pB1, 14)};
      SBAR(); pv(o, vb0 + sl_cur, PAF(0), PAF(1), PAF(2), PAF(3)); }
#undef XMASKB
#undef PKW
#undef PAF
#undef VFR
#undef PIN
#undef MX3
#undef GAPA
#undef GAPB
#undef EX
#undef VRD
#undef KRD
#undef STEP
#undef ENDW
    { auto rr = __builtin_amdgcn_permlane32_swap(__float_as_uint(l_reg), __float_as_uint(l_reg), false, false); l_reg = __uint_as_float(rr[0]) + __uint_as_float(rr[1]); }
    if (hi == 0) wsf[32 + r32] = l_reg; asm volatile("s_waitcnt lgkmcnt(0)" ::: "memory");
    float rli[16];
#pragma unroll
    for (int r = 0; r < 16; ++r) rli[r] = __builtin_amdgcn_rcpf(wsf[32 + crow(r, hi)]);
    bf16* Ow = O + (rowbase + q0 + wid * QBLK) * OP + h * D;
    { bf16* stg = (bf16*)(shm + LDS_OST) + wid * 2048;
#pragma unroll
      for (int r = 0; r < 16; ++r) { const int orow = crow(r, hi);
#pragma unroll
          for (int d0 = 0; d0 < 2; ++d0) stg[orow * 64 + d0 * 32 + r32] = __float2bfloat16(o[d0][r] * rli[r]); }
      asm volatile("s_waitcnt lgkmcnt(0)" ::: "memory");
#pragma unroll
      for (int i = 0; i < 4; ++i) { const int row = i * 8 + (lane >> 3), ch = lane & 7; const u32x4 v = *(const u32x4*)(stg + row * 64 + ch * 8); *(u32x4*)(Ow + (long)row * OP + ch * 8) = v; } }
    asm volatile("s_waitcnt lgkmcnt(0)\n\ts_barrier" ::: "memory");
#undef DMA_K
#undef DMA_V
#undef XMB
#undef LDM
#undef START
#undef RESC
#undef ROT
}
#undef SBAR
#undef WAIT_BAR
}

#define XB_TMO      128
#define XB_XCNT(j)  (256  + 64 * (j))
#define XB_XSUB(j)  (1280 + 64 * (j))
#define XB_XGEN(j)  (2304 + 64 * (j))
#define XB_TOP      3328
#define XB_TOPGEN   3392
#define XCD_BAR_WORDS 3456
#define XB_SPIN_CAP (1u << 18)
__device__ __forceinline__ unsigned xb_ld(unsigned* p)              { return __hip_atomic_load(p, __ATOMIC_RELAXED, __HIP_MEMORY_SCOPE_AGENT); }
__device__ __forceinline__ unsigned xb_add(unsigned* p, unsigned v) { return __hip_atomic_fetch_add(p, v, __ATOMIC_RELAXED, __HIP_MEMORY_SCOPE_AGENT); }
__device__ __forceinline__ unsigned xb_xcc_id() { return (unsigned)__builtin_amdgcn_s_getreg((3 << 11) | 20) & 0xFu; }
#define XB_SPIN(cond, bar) do { unsigned _sp = 0; while (cond) { __builtin_amdgcn_s_sleep(1); \
    if ((++_sp & 255u) == 0u) { if (xb_ld(&(bar)[XB_TMO])) break; if (_sp > XB_SPIN_CAP) { atomicAdd(&(bar)[XB_TMO], 1u); break; } } } } while (0)
struct XcdBarrier { unsigned* bar; unsigned x; volatile LAS unsigned* st; };
__device__ __forceinline__ XcdBarrier xcd_barrier_post(unsigned* bar, volatile LAS unsigned* st) {
    XcdBarrier b; b.bar = bar; b.x = xb_xcc_id(); b.st = st;
    if (threadIdx.x == 0) (void)xb_add(&bar[XB_XCNT(b.x)], 1u);
    return b;
}
__device__ __forceinline__ void xcd_barrier_complete(unsigned* bar, unsigned x, unsigned& nloc, unsigned& nx) {
    const unsigned G = gridDim.x * gridDim.y * gridDim.z;
    unsigned sum, cnt, mine, sp = 0u;
    for (;;) {
        sum = 0u; cnt = 0u; mine = 0u;
#pragma unroll
        for (unsigned j = 0; j < 16; ++j) { const unsigned c = xb_ld(&bar[XB_XCNT(j)]); sum += c; cnt += (c > 0u) ? 1u : 0u; mine = (j == x) ? c : mine; }
        if (sum == G) break;
        __builtin_amdgcn_s_sleep(1);
        if ((++sp & 255u) == 0u) { if (xb_ld(&bar[XB_TMO])) break; if (sp > XB_SPIN_CAP) { atomicAdd(&bar[XB_TMO], 1u); break; } }
    }
    nloc = mine > 0u ? mine : 1u; nx = cnt > 0u ? cnt : 1u;
}
__device__ __forceinline__ void xcd_barrier(const XcdBarrier& b) {
    asm volatile("s_waitcnt vmcnt(0)" ::: "memory");
    __syncthreads();
    if (threadIdx.x == 0) {
        unsigned* bar = b.bar;
        __builtin_amdgcn_s_waitcnt(0);
        unsigned nloc = b.st[0], nx = b.st[1];
        if (nloc == 0u) { xcd_barrier_complete(bar, b.x, nloc, nx); b.st[0] = nloc; b.st[1] = nx; }
        const unsigned old = xb_add(&bar[XB_XSUB(b.x)], 1u);
        const unsigned gen = old / nloc;
        if (old + 1u == (gen + 1u) * nloc) {
            __builtin_amdgcn_fence(__ATOMIC_RELEASE, "agent");
            asm volatile("s_waitcnt vmcnt(0)" ::: "memory");
            const unsigned og = xb_add(&bar[XB_TOP], 1u);
            const unsigned tg = og / nx;
            if (og + 1u == (tg + 1u) * nx) xb_add(&bar[XB_TOPGEN], 1u);
            else XB_SPIN(xb_ld(&bar[XB_TOPGEN]) == tg, bar);
            __builtin_amdgcn_fence(__ATOMIC_ACQUIRE, "agent");
            xb_add(&bar[XB_XGEN(b.x)], 1u);
            asm volatile("s_waitcnt vmcnt(0)" ::: "memory");
        } else {
            XB_SPIN(xb_ld(&bar[XB_XGEN(b.x)]) == gen, bar);
            __builtin_amdgcn_fence(__ATOMIC_ACQUIRE, "agent");
            asm volatile("s_waitcnt vmcnt(0)" ::: "memory");
        }
    }
    __syncthreads();
}

constexpr int NWAVES = 8;
struct Args { const float* in[17]; float* out; unsigned char* ws; int ph_lo, ph_hi; };
__device__ __forceinline__ const float* inp(int k) { return ((const float* const __attribute__((address_space(4)))*)__builtin_amdgcn_kernarg_segment_ptr())[k]; }
struct Frame {
    LAS unsigned char* lds;
    gu32* ctl;
    unsigned char* ws;
    int tid, lane, wave, vcu, G;
    float* out;
};

template <class SrcCol, class DstRow>
__device__ __forceinline__ void p0_transpose_item(const float* W, int K, int ldN, bf16_t* WT, LAS float* scr, int k0, int n0, int lane, SrcCol srccol, DstRow dstrow) {
    const int sc = srccol(n0 + (lane & 31));
#pragma unroll 8
    for (int i = 0; i < 32; ++i) { const int kk = 2 * i + (lane >> 5); scr[kk * 33 + (lane & 31)] = sc >= 0 ? W[(size_t)(k0 + kk) * ldN + sc] : 0.f; }
    LDS_WAIT(); asm volatile("" ::: "memory");
    const int c = lane & 7;
#pragma unroll
    for (int j = 0; j < 4; ++j) { const int n = (lane >> 3) + 8 * j; const LAS float* s = scr + (8 * c) * 33 + n;
        v4u o; o.x = pk2(s[0 * 33], s[1 * 33]); o.y = pk2(s[2 * 33], s[3 * 33]); o.z = pk2(s[4 * 33], s[5 * 33]); o.w = pk2(s[6 * 33], s[7 * 33]);
        *(GAS v4u*)(WT + (size_t)dstrow(n0 + n) * K + k0 + 8 * c) = o; }
    LDS_WAIT(); asm volatile("" ::: "memory");
}
__device__ __forceinline__ int rel_bucket_dev(int n) {
    if (n < 16) return n;
    int v = 16 + (int)(logf((float)n / 16.f) / logf(8.f) * 16.f);
    return v < 31 ? v : 31;
}

__device__ __forceinline__ void p0_prologue(Frame& F, const Args& A) {
    const float* x = inp(0); const float* w_in = inp(1); const float* w_pool = inp(2); const float* pool_scale = inp(3); const float* w_out = inp(4);
    const float* rel_bias = inp(5); const float* w_r1 = inp(8); const float* w_r2 = inp(10); const float* w_gate = inp(12); const float* w_up = inp(13); const float* w_down = inp(14);
    bf16_t* WIN = (bf16_t*)(F.ws + WS_WIN); bf16_t* WOUT = (bf16_t*)(F.ws + WS_WOUT); bf16_t* WPBD = (bf16_t*)(F.ws + WS_WPBD);
    bf16_t* WGU = (bf16_t*)(F.ws + WS_WGU); bf16_t* WD = (bf16_t*)(F.ws + WS_WD); bf16_t* XB = (bf16_t*)(F.ws + WS_XB);
    float* WRT = (float*)(F.ws + WS_WRT); float* BT = (float*)(F.ws + WS_BIAS);
    LAS float* scr = (LAS float*)(F.lds + F.wave * 16384);
    const int gw = F.vcu * NWAVES + F.wave, NGW = F.G * NWAVES;
    constexpr int I_IN = 16 * (NIN / 32), I_OUT = 16 * 32, I_GU = 32 * 2 * 16 * 8, I_D = 32 * 4 * 32;
    constexpr int NITEMS = I_IN + I_OUT + I_GU + I_D;
    for (int it = gw; it < NITEMS; it += NGW) {
        int r = it;
        if (r < I_IN) { const int kb = r / (NIN / 32), nb = r % (NIN / 32);
            p0_transpose_item(w_in, DM, IN_W, WIN, scr, kb * 64, nb * 32, F.lane,
                [](int n) { return n < 2048 ? n : (n < 2560 ? n - 2048 + P_OFF : (n < 2624 ? n - 2560 + IK_OFF : (n < 2632 ? n - 2624 + IW_OFF : -1))); },
                [](int n) { return n; });
            continue; } r -= I_IN;
        if (r < I_OUT) { const int kb = r / 32, nb = r % 32;
            p0_transpose_item(w_out, DM, DM, WOUT, scr, kb * 64, nb * 32, F.lane, [](int n) { return n; }, [](int n) { return n; });
            continue; } r -= I_OUT;
        if (r < I_GU) { const int e = r / 256, bj = (r / 128) & 1, q = r % 128, kb = q / 8, nb = q % 8;
            const float* W = (bj ? w_up : w_gate) + (size_t)e * DM * DEXP;
            p0_transpose_item(W, DM, DEXP, WGU, scr, kb * 64, nb * 32, F.lane, [](int n) { return n; },
                [e, bj](int n) { return e * 512 + (n >> 7) * 256 + bj * 128 + (n & 127); });
            continue; } r -= I_GU;
        { const int e = r / 128, q = r % 128, kb = q / 32, nb = q % 32;
            p0_transpose_item(w_down + (size_t)e * DEXP * DM, DEXP, DM, WD, scr, kb * 64, nb * 32, F.lane, [](int n) { return n; }, [e](int n) { return e * 1024 + n; }); }
    }
    { const int gt = F.vcu * (NWAVES * 64) + F.tid, NGT = F.G * NWAVES * 64;
      for (int i = gt; i < M * DM / 8; i += NGT) { const f32x4 a = *(const GAS f32x4*)(x + (size_t)i * 8), b = *(const GAS f32x4*)(x + (size_t)i * 8 + 4);
          v4u o; o.x = pk2(a.x, a.y); o.y = pk2(a.z, a.w); o.z = pk2(b.x, b.y); o.w = pk2(b.z, b.w); *(GAS v4u*)(XB + (size_t)i * 8) = o; }
      for (int i = gt; i < 512 * 64; i += NGT) { const int dg = i / 64, c0 = (i % 64) * 8, g = dg >> 7, d = dg & 127; unsigned short o[8];
#pragma unroll
          for (int j = 0; j < 8; ++j) { const int cg = c0 + j; float v = 0.f; if ((cg >> 7) == g) v = w_pool[((size_t)g * 128 + (cg & 127)) * 128 + d] * pool_scale[dg]; o[j] = (unsigned short)f2bf(v); }
          v4u w; w.x = o[0] | (o[1] << 16); w.y = o[2] | (o[3] << 16); w.z = o[4] | (o[5] << 16); w.w = o[6] | (o[7] << 16); *(GAS v4u*)(WPBD + (size_t)dg * 512 + c0) = w; }
      for (int i = gt; i < 36 * 1024; i += NGT) { const int o = i / 1024, k = i % 1024; WRT[i] = o < 4 ? w_r1[k * 4 + o] : w_r2[k * 32 + (o - 4)]; }
      for (int i = gt; i < 8 * 1024; i += NGT) { const int h = i / 1024, ii = i % 1024, dist = 448 - ii; float v = 0.f;
          if (dist >= 0 && dist < 128) v = (rel_bias[rel_bucket_dev(dist) * 8 + h] - rel_bias[31 * 8 + h]) * LOG2E;
          BT[i] = v; }
    }
}

__device__ __forceinline__ void p2_pool(Frame& F) {
    const bf16_t* U = (const bf16_t*)(F.ws + WS_U); bf16_t* PO = (bf16_t*)(F.ws + WS_POOLED);
    const int gt = F.vcu * (NWAVES * 64) + F.tid, NGT = F.G * NWAVES * 64;
    for (int i = gt; i < M * 64; i += NGT) {
        const int row = i >> 6, ch = i & 63, tpos = row & (SEQ - 1), g = ch >> 4, w = 2 << g;
        const int cnt = (tpos + 1) < w ? (tpos + 1) : w;
        float s[8];
#pragma unroll
        for (int j = 0; j < 8; ++j) s[j] = 0.f;
        float u0[8];
#pragma unroll
        for (int k = 0; k < 16; ++k) {
            if (k < cnt) { const v4u v = *(const GAS v4u*)(U + (size_t)(row - k) * AW + ch * 8);
                const unsigned ww[4] = {v.x, v.y, v.z, v.w};
#pragma unroll
                for (int j = 0; j < 4; ++j) { const float lo = __builtin_bit_cast(float, ww[j] << 16), hi = __builtin_bit_cast(float, ww[j] & 0xffff0000u); s[2 * j] += lo; s[2 * j + 1] += hi;
                    if (k == 0) { u0[2 * j] = lo; u0[2 * j + 1] = hi; } } }
        }
        const float inv = 1.f / (float)cnt; v4u o;
        o.x = pk2(s[0] * inv - u0[0], s[1] * inv - u0[1]); o.y = pk2(s[2] * inv - u0[2], s[3] * inv - u0[3]);
        o.z = pk2(s[4] * inv - u0[4], s[5] * inv - u0[5]); o.w = pk2(s[6] * inv - u0[6], s[7] * inv - u0[7]);
        *(GAS v4u*)(PO + (size_t)row * AW + ch * 8) = o;
    }
}

__device__ __forceinline__ unsigned key2(float s0, float s1) {
    const auto hh = __builtin_amdgcn_cvt_pkrtz(s0, s1); unsigned u = __builtin_bit_cast(unsigned, hh);
    const unsigned sg = u & 0x80008000u; const unsigned m = (sg >> 15) * 0xffffu;
    return u ^ (m | 0x80008000u);
}

__device__ __forceinline__ void p2_indexer(Frame& F) {
    const bf16_t* IQ = (const bf16_t*)(F.ws + WS_IQ); const bf16_t* IK = (const bf16_t*)(F.ws + WS_IK); const float* IW = (const float*)(F.ws + WS_IW);
    unsigned* MASKQ = (unsigned*)(F.ws + WS_MASK);
    LAS unsigned short* SC = (LAS unsigned short*)F.lds;
    LAS unsigned* HIST = (LAS unsigned*)(F.lds + LDS_HIST + F.wave * 2048);
    LAS unsigned char* MST = (LAS unsigned char*)(F.lds + LDS_MST);
    LAS float* WT = (LAS float*)(F.lds + LDS_WT);
    const int lane = F.lane, wave = F.wave, n32 = lane & 31, kh = lane >> 5;
    constexpr float SSC = 0.04419417382f;
    const int npairs = BATCH * 128;
#pragma unroll 1
    for (int p = F.vcu; p < npairs; p += F.G)
#pragma unroll 1
      for (int half = 0; half < 2; ++half) {
        const int b = p >> 7, s_ = p & 127, qt = half ? 255 - s_ : s_;
        const int t0 = qt * 16; const long rb = (long)b * SEQ;
        const int nkt = (t0 + 16 + 31) >> 5;
        if (F.tid < 128) WT[F.tid] = IW[(rb + t0) * 8 + F.tid];
        bf16x8 a[4][4];
        { const int rho = n32, tl_ = 2 * ((rho >> 2) & 1) + (rho >> 4), j = (rho & 3) + 4 * ((rho >> 3) & 1);
#pragma unroll
          for (int i = 0; i < 4; ++i)
#pragma unroll
              for (int ks = 0; ks < 4; ++ks) a[i][ks] = *(const GAS bf16x8*)(IQ + (size_t)(rb + t0 + 4 * i + tl_) * AW + j * 64 + ks * 16 + kh * 8); }
        __syncthreads();
#pragma unroll 1
        for (int kt = wave; kt < nkt; kt += NWAVES) {
            const int key = 32 * kt + n32;
            bf16x8 bfr[4];
#pragma unroll
            for (int ks = 0; ks < 4; ++ks) bfr[ks] = *(const GAS bf16x8*)(IK + (size_t)(rb + key) * 64 + ks * 16 + kh * 8);
#pragma unroll
            for (int i = 0; i < 4; ++i) {
                f32x16 acc = f32x16{};
#pragma unroll
                for (int ks = 0; ks < 4; ++ks) acc = __builtin_amdgcn_mfma_f32_32x32x16_bf16(a[i][ks], bfr[ks], acc, 0, 0, 0);
                const int ta = 4 * i + 2 * kh;
                const f32x4 w0a = *(const LAS f32x4*)(WT + ta * 8), w0b = *(const LAS f32x4*)(WT + ta * 8 + 4), w1a = *(const LAS f32x4*)(WT + ta * 8 + 8), w1b = *(const LAS f32x4*)(WT + ta * 8 + 12);
                float s0 = 0.f, s1 = 0.f;
#pragma unroll
                for (int j = 0; j < 4; ++j) { s0 += w0a[j] * __builtin_fmaxf(acc[j], 0.f); s1 += w1a[j] * __builtin_fmaxf(acc[8 + j], 0.f); }
#pragma unroll
                for (int j = 0; j < 4; ++j) { s0 += w0b[j] * __builtin_fmaxf(acc[4 + j], 0.f); s1 += w1b[j] * __builtin_fmaxf(acc[12 + j], 0.f); }
                const unsigned kk = key2(s0 * SSC, s1 * SSC);
                SC[ta * 4096 + key] = (unsigned short)(kk & 0xffffu); SC[(ta + 1) * 4096 + key] = (unsigned short)(kk >> 16);
            }
        }
        __syncthreads();
#pragma unroll 1
        for (int qq = 0; qq < 2; ++qq) {
            const int ql = 2 * wave + qq, t = t0 + ql;
            const LAS unsigned short* rowp = SC + ql * 4096;
            v4u v[8];
#pragma unroll
            for (int i = 0; i < 8; ++i) { const int c = i * 64 + lane; v[i] = *(const LAS v4u*)(rowp + 8 * c);
                const int nv = t + 1 - 8 * c;
#pragma unroll
                for (int w = 0; w < 4; ++w) { int bits = 16 * nv - 32 * w; bits = bits < 0 ? 0 : (bits > 32 ? 32 : bits); v[i][w] &= (unsigned)((1ull << bits) - 1ull); } }
            unsigned T = 1u; int need_eq = 0, n_eq = 0; bool all = (t + 1 <= 256);
            if (!all) {
#pragma unroll
                for (int w = 0; w < 8; ++w) HIST[w * 64 + lane] = 0u;
                LDS_WAIT();
#pragma unroll
                for (int i = 0; i < 8; ++i)
#pragma unroll
                    for (int w = 0; w < 4; ++w) { const unsigned x = v[i][w]; const unsigned k0 = x & 0xffffu, k1 = x >> 16;
                        if (k0) LADD(HIST + (k0 >> 7), 1u << (16 * ((k0 >> 6) & 1)));
                        if (k1) LADD(HIST + (k1 >> 7), 1u << (16 * ((k1 >> 6) & 1))); }
                LDS_WAIT();
                unsigned hw[8]; { const v4u h0 = *(const LAS v4u*)(HIST + 8 * lane), h1 = *(const LAS v4u*)(HIST + 8 * lane + 4); hw[0] = h0.x; hw[1] = h0.y; hw[2] = h0.z; hw[3] = h0.w; hw[4] = h1.x; hw[5] = h1.y; hw[6] = h1.z; hw[7] = h1.w; }
                int sl = 0;
#pragma unroll
                for (int w = 0; w < 8; ++w) sl += (int)(hw[w] & 0xffffu) + (int)(hw[w] >> 16);
                int Ssum = sl;
#pragma unroll
                for (int d = 1; d < 64; d <<= 1) { const int o = __shfl_down(Ssum, d); if (lane + d < 64) Ssum += o; }
                const int above = Ssum - sl;
                int fb = -1, fa = 0; { int run = above;
#pragma unroll
                    for (int bb = 15; bb >= 0; --bb) { const int c = (int)((hw[bb >> 1] >> (16 * (bb & 1))) & 0xffffu); if (fb < 0 && run + c >= 256) { fb = bb; fa = run; } run += c; } }
                const bool cross = (above < 256) && (Ssum >= 256);
                const unsigned long long bm = __ballot(cross); const int src = bm ? (int)__builtin_ctzll(bm) : 0;
                const int B1 = __builtin_amdgcn_readlane(16 * lane + fb, src) , cnt_above = __builtin_amdgcn_readlane(fa, src);
                LDS_WAIT(); HIST[lane] = 0u; LDS_WAIT();
#pragma unroll
                for (int i = 0; i < 8; ++i)
#pragma unroll
                    for (int w = 0; w < 4; ++w) { const unsigned x = v[i][w]; const unsigned k0 = x & 0xffffu, k1 = x >> 16;
                        if ((int)(k0 >> 6) == B1) LADD(HIST + (k0 & 63u), 1u);
                        if ((int)(k1 >> 6) == B1) LADD(HIST + (k1 & 63u), 1u); }
                LDS_WAIT();
                const int need2 = 256 - cnt_above;
                const int c2 = (int)HIST[lane];
                int S2 = c2;
#pragma unroll
                for (int d = 1; d < 64; d <<= 1) { const int o = __shfl_down(S2, d); if (lane + d < 64) S2 += o; }
                const bool cross2 = (S2 - c2 < need2) && (S2 >= need2);
                const unsigned long long bm2 = __ballot(cross2); const int B2 = bm2 ? (int)__builtin_ctzll(bm2) : 0;
                const int above2 = __builtin_amdgcn_readlane(S2 - c2, B2);
                n_eq = __builtin_amdgcn_readlane(c2, B2);
                T = ((unsigned)B1 << 6) | (unsigned)B2;
                need_eq = need2 - above2;
                LDS_WAIT();
            }
            const bool ties = (!all) && (need_eq < n_eq);
            int tie_base = 0;
#pragma unroll
            for (int i = 0; i < 8; ++i) {
                unsigned gt_bits = 0u, eq_bits = 0u;
#pragma unroll
                for (int w = 0; w < 4; ++w) { const unsigned x = v[i][w]; const unsigned k0 = x & 0xffffu, k1 = x >> 16;
                    gt_bits |= (k0 > T ? 1u : 0u) << (2 * w); gt_bits |= (k1 > T ? 1u : 0u) << (2 * w + 1);
                    eq_bits |= (k0 == T ? 1u : 0u) << (2 * w); eq_bits |= (k1 == T ? 1u : 0u) << (2 * w + 1); }
                unsigned sel;
                if (all) { sel = 0u;
#pragma unroll
                    for (int w = 0; w < 4; ++w) { const unsigned x = v[i][w]; sel |= ((x & 0xffffu) ? 1u : 0u) << (2 * w); sel |= ((x >> 16) ? 1u : 0u) << (2 * w + 1); } }
                else if (!ties) sel = gt_bits | eq_bits;
                else {
                    const int pc = __builtin_popcount(eq_bits);
                    int incl = pc;
#pragma unroll
                    for (int d = 1; d < 64; d <<= 1) { const int o = __shfl_up(incl, d); if (lane >= d) incl += o; }
                    const int excl = tie_base + incl - pc;
                    unsigned keep = 0u; int rk = excl;
#pragma unroll
                    for (int e = 0; e < 8; ++e) { if ((eq_bits >> e) & 1u) { if (rk < need_eq) keep |= 1u << e; ++rk; } }
                    tie_base += __builtin_amdgcn_readlane(incl, 63);
                    sel = gt_bits | keep;
                }
                MST[ql * 512 + i * 64 + lane] = (unsigned char)sel;
            }
        }
        __syncthreads();
        { const v4u mv = *(const LAS v4u*)(MST + F.tid * 16); *(GAS v4u*)((unsigned char*)MASKQ + (size_t)(rb + t0) * 512 + F.tid * 16) = mv; }
        __syncthreads();
      }
}

__device__ __forceinline__ void p5_ln1_router(Frame& F, const Args& A) {
    const float* x = inp(0); const float* g1 = inp(6); const float* b1 = inp(7); const float* b_r1 = inp(9); const float* b_r2 = inp(11);
    const float* MIX = (const float*)(F.ws + WS_MIX); float* H1 = F.out; bf16_t* H1B = (bf16_t*)(F.ws + WS_H1B);
    int* RE = (int*)(F.ws + WS_RE); float* RW = (float*)(F.ws + WS_RW);
    const float* WRT = (const float*)(F.ws + WS_WRT);
    LAS float* WL = (LAS float*)F.lds;
    LAS int* lcnt = (LAS int*)(F.lds + LDS_TBL + 1024);
    for (int i = F.tid; i < 36 * 1024 / 4; i += NWAVES * 64) ((LAS f32x4*)WL)[i] = ((const GAS f32x4*)WRT)[i];
    if (F.tid < 32) lcnt[F.tid] = 0;
    __syncthreads();
    const int lane = F.lane; const int gw = F.vcu * NWAVES + F.wave, NGW = F.G * NWAVES;
    f32x4 gg[4], bb[4];
#pragma unroll
    for (int j = 0; j < 4; ++j) { gg[j] = *(const GAS f32x4*)(g1 + 256 * j + 4 * lane); bb[j] = *(const GAS f32x4*)(b1 + 256 * j + 4 * lane); }
    for (int m = gw; m < M; m += NGW) {
        f32x4 v[4]; float s = 0.f;
#pragma unroll
        for (int j = 0; j < 4; ++j) { const f32x4 xv = *(const GAS f32x4*)(x + (size_t)m * DM + 256 * j + 4 * lane), mv = *(const GAS f32x4*)(MIX + (size_t)m * DM + 256 * j + 4 * lane);
            v[j] = xv * ALPHA + mv; s += (v[j].x + v[j].y) + (v[j].z + v[j].w); }
        const float mean = wave_sum(s) * (1.f / DM); float s2 = 0.f;
#pragma unroll
        for (int j = 0; j < 4; ++j) { v[j] = v[j] - mean; s2 += (v[j].x * v[j].x + v[j].y * v[j].y) + (v[j].z * v[j].z + v[j].w * v[j].w); }
        const float rstd = 1.f / sqrtf(wave_sum(s2) * (1.f / DM) + LN_EPS);
#pragma unroll
        for (int j = 0; j < 4; ++j) { v[j] = v[j] * rstd * gg[j] + bb[j];
            *(GAS f32x4*)(H1 + (size_t)m * DM + 256 * j + 4 * lane) = v[j];
            v2u o; o.x = pk2(v[j].x, v[j].y); o.y = pk2(v[j].z, v[j].w); *(GAS v2u*)(H1B + (size_t)m * DM + 256 * j + 4 * lane) = o; }
        float lg[36];
#pragma unroll
        for (int o = 0; o < 36; ++o) { float pacc = 0.f;
#pragma unroll
            for (int j = 0; j < 4; ++j) { const f32x4 w = *(const LAS f32x4*)(WL + o * 1024 + 256 * j + 4 * lane); pacc += (v[j].x * w.x + v[j].y * w.y) + (v[j].z * w.z + v[j].w * w.w); }
            lg[o] = wave_sum(pacc); }
        float l4[4]; int g = 0; float mx = -INFINITY;
#pragma unroll
        for (int i = 0; i < 4; ++i) { l4[i] = lg[i] + b_r1[i]; if (l4[i] > mx) { mx = l4[i]; g = i; } }
        float z = 0.f;
#pragma unroll
        for (int i = 0; i < 4; ++i) z += expf(l4[i] - mx);
        const float pg_top = 1.f / z;
        float l8[8];
#pragma unroll
        for (int e = 0; e < 8; ++e) { const float a0 = lg[4 + e], a1 = lg[12 + e], a2 = lg[20 + e], a3 = lg[28 + e]; l8[e] = (g == 0 ? a0 : (g == 1 ? a1 : (g == 2 ? a2 : a3))) + b_r2[g * 8 + e]; }
        int e0 = 0; float m0 = -INFINITY;
#pragma unroll
        for (int e = 0; e < 8; ++e) if (l8[e] > m0) { m0 = l8[e]; e0 = e; }
        int e1 = 0; float m1 = -INFINITY;
#pragma unroll
        for (int e = 0; e < 8; ++e) if (e != e0 && l8[e] > m1) { m1 = l8[e]; e1 = e; }
        const float r = expf(m1 - m0); const float w0 = pg_top / (1.f + r), w1 = pg_top * r / (1.f + r);
        if (lane == 0) { RE[2 * m] = g * 8 + e0; RE[2 * m + 1] = g * 8 + e1; RW[2 * m] = w0; RW[2 * m + 1] = w1;
            LADD(lcnt + g * 8 + e0, 1); LADD(lcnt + g * 8 + e1, 1); }
    }
    __syncthreads();
    if (F.tid < 32) { const int c = lcnt[F.tid]; if (c) __hip_atomic_fetch_add((unsigned*)(F.ctl + CW_CNT + F.tid), (unsigned)c, RLX_AGENT); }
}

__device__ __forceinline__ int moe_table(Frame& F) {
    LAS int* toff = (LAS int*)(F.lds + LDS_TBL); LAS int* tile_e = toff + 40;
    __syncthreads();
    if (F.tid == 0) { int acc = 0; for (int e = 0; e < 32; ++e) { toff[e] = acc; const unsigned n = __hip_atomic_load((unsigned*)(F.ctl + CW_CNT + e), RLX_AGENT); acc += (int)((n + 255u) >> 8); } toff[32] = acc; }
    __syncthreads();
    const int RT = toff[32];
    if (F.tid < 32) { for (int k = toff[F.tid]; k < toff[F.tid + 1]; ++k) tile_e[k] = F.tid; }
    __syncthreads();
    return RT < 160 ? RT : 160;
}

__device__ __forceinline__ void p6_positions(Frame& F) {
    (void)moe_table(F);
    LAS int* toff = (LAS int*)(F.lds + LDS_TBL); LAS int* lcnt = (LAS int*)(F.lds + LDS_TBL + 1024); LAS int* base = lcnt + 32;
    const int* RE = (const int*)(F.ws + WS_RE); const float* RW = (const float*)(F.ws + WS_RW); int* POS = (int*)(F.ws + WS_POS); float* WROW = (float*)(F.ws + WS_WROW);
    int* rowidx = (int*)(F.ctl + CW_ROWIDX);
    for (int chunk = F.vcu; chunk < M / 64; chunk += F.G) {
        if (F.tid < 32) lcnt[F.tid] = 0;
        __syncthreads();
        int e = 0, r = 0, tok = 0;
        if (F.tid < 128) { tok = chunk * 64 + (F.tid >> 1); e = RE[2 * tok + (F.tid & 1)]; r = LADD(lcnt + e, 1); }
        __syncthreads();
        if (F.tid < 32) { const int c = lcnt[F.tid]; base[F.tid] = c ? (int)__hip_atomic_fetch_add((unsigned*)(F.ctl + CW_CUR + F.tid), (unsigned)c, RLX_AGENT) : 0; }
        __syncthreads();
        if (F.tid < 128) { const int pos = toff[e] * 256 + base[e] + r; if (pos < MAXROWS) { rowidx[pos] = tok; WROW[pos] = RW[2 * tok + (F.tid & 1)]; } POS[2 * tok + (F.tid & 1)] = pos; }
        __syncthreads();
    }
}

__device__ __forceinline__ void p9_ln2(Frame& F, const Args& A) {
    const float* g2 = inp(15); const float* b2 = inp(16);
    float* H1 = F.out; const bf16_t* YS = (const bf16_t*)(F.ws + WS_YS); const int* POS = (const int*)(F.ws + WS_POS);
    const int lane = F.lane; const int gw = F.vcu * NWAVES + F.wave, NGW = F.G * NWAVES;
    f32x4 gg[4], bb[4];
#pragma unroll
    for (int j = 0; j < 4; ++j) { gg[j] = *(const GAS f32x4*)(g2 + 256 * j + 4 * lane); bb[j] = *(const GAS f32x4*)(b2 + 256 * j + 4 * lane); }
    for (int m = gw; m < M; m += NGW) {
        const int p0 = POS[2 * m], p1 = POS[2 * m + 1];
        f32x4 v[4]; float s = 0.f;
#pragma unroll
        for (int j = 0; j < 4; ++j) { const f32x4 hv = *(const GAS f32x4*)(H1 + (size_t)m * DM + 256 * j + 4 * lane);
            const v2u y0 = *(const GAS v2u*)(YS + (size_t)p0 * DM + 256 * j + 4 * lane), y1 = *(const GAS v2u*)(YS + (size_t)p1 * DM + 256 * j + 4 * lane);
            f32x4 yy; yy.x = __builtin_bit_cast(float, y0.x << 16) + __builtin_bit_cast(float, y1.x << 16); yy.y = __builtin_bit_cast(float, y0.x & 0xffff0000u) + __builtin_bit_cast(float, y1.x & 0xffff0000u);
            yy.z = __builtin_bit_cast(float, y0.y << 16) + __builtin_bit_cast(float, y1.y << 16); yy.w = __builtin_bit_cast(float, y0.y & 0xffff0000u) + __builtin_bit_cast(float, y1.y & 0xffff0000u);
            v[j] = hv * ALPHA + yy; s += (v[j].x + v[j].y) + (v[j].z + v[j].w); }
        const float mean = wave_sum(s) * (1.f / DM); float s2 = 0.f;
#pragma unroll
        for (int j = 0; j < 4; ++j) { v[j] = v[j] - mean; s2 += (v[j].x * v[j].x + v[j].y * v[j].y) + (v[j].z * v[j].z + v[j].w * v[j].w); }
        const float rstd = 1.f / sqrtf(wave_sum(s2) * (1.f / DM) + LN_EPS);
#pragma unroll
        for (int j = 0; j < 4; ++j) *(GAS f32x4*)(H1 + (size_t)m * DM + 256 * j + 4 * lane) = v[j] * rstd * gg[j] + bb[j];
    }
}

constexpr int N_PHASES = 10;
__global__ void __launch_bounds__(NWAVES * 64, 2) fwd_kernel(Args args) {
    extern __shared__ __attribute__((aligned(16))) unsigned char lds[];
    Frame F;
    F.lds = (LAS unsigned char*)lds;
    F.tid = threadIdx.x; F.lane = F.tid & 63; F.wave = __builtin_amdgcn_readfirstlane(F.tid >> 6);
    F.G = gridDim.x; { const int bx = blockIdx.x; F.vcu = (F.G % 8 == 0) ? (bx % 8) * (F.G / 8) + bx / 8 : bx; }
    F.ws = args.ws; F.ctl = (gu32*)(args.ws + WS_CTL); F.out = args.out;
    volatile LAS unsigned* MISC = (volatile LAS unsigned*)(F.lds + LDS_MISC);
    if (F.tid < 32) MISC[F.tid] = 0u;
    __syncthreads();
    const int lo = args.ph_lo, hi = args.ph_hi;
    const bool one = (hi - lo) > 1;
    XcdBarrier bar; bar.bar = (unsigned*)(F.ctl + CW_BAR); bar.x = 0; bar.st = nullptr;
    if (one) bar = xcd_barrier_post((unsigned*)(F.ctl + CW_BAR), MISC + 8);
#ifndef PHASE_MASK
#define PHASE_MASK 0x3ff
#endif
#define IN(k) (((PHASE_MASK >> (k)) & 1) && lo <= (k) && (k) < hi)
#define SEAM(k) do { if (IN(k) && IN((k) + 1)) xcd_barrier(bar); } while (0)

    if (IN(0)) { p0_prologue(F, args); } SEAM(0);

    if (IN(1)) {
        pg8::Gemm g{(const bf16_t*)(F.ws + WS_XB), (const bf16_t*)(F.ws + WS_WIN), DM, nullptr}; pg8::StaticOrder S; S.init(M, NIN, F.G, (int)blockIdx.x);
        pg8::EpiInProj E{(bf16_t*)(F.ws + WS_Q), (bf16_t*)(F.ws + WS_IK), (float*)(F.ws + WS_IW)};
        pg8::gemm_phase<pg8::EpiInProj, pg8::StaticOrder, true>(F.lds, g, S, E);
    } SEAM(1);

    if (IN(2)) { p2_pool(F); p2_indexer(F); } SEAM(2);

    if (IN(3)) {
        const float* BT = (const float*)(F.ws + WS_BIAS);
        LAS float* btab = (LAS float*)(F.lds + LDS_BIAS);
        for (int v = F.vcu; v < 256; v += F.G) {
            const int bh = v >> 3, s = v & 7, b = bh >> 3, h = bh & 7;
            __syncthreads();
            for (int i = F.tid; i < 1024; i += NWAVES * 64) btab[i] = BT[h * 1024 + i];
            __syncthreads();
            for (int k = 0; k < 2; ++k) {
                const int qb = k ? 15 - s : s;
                attn_body::attn_unit<8>(b, h, qb, (const attn_body::bf16*)(F.ws + WS_Q), (const attn_body::bf16*)(F.ws + WS_K), (const attn_body::bf16*)(F.ws + WS_V),
                                        (attn_body::bf16*)(F.ws + WS_AP), (const unsigned*)(F.ws + WS_MASK), btab, (char*)lds);
            }
        }
        __syncthreads();
        pg8::Gemm g{(const bf16_t*)(F.ws + WS_POOLED), (const bf16_t*)(F.ws + WS_WPBD), AW, nullptr}; pg8::StaticOrder S; S.init(M, AW, F.G, (int)blockIdx.x);
        pg8::EpiBf16Plain E{(bf16_t*)(F.ws + WS_AP), DM, AW};
        pg8::gemm_phase<pg8::EpiBf16Plain, pg8::StaticOrder, true>(F.lds, g, S, E);
    } SEAM(3);

    if (IN(4)) {
        pg8::Gemm g{(const bf16_t*)(F.ws + WS_AP), (const bf16_t*)(F.ws + WS_WOUT), DM, nullptr}; pg8::StaticOrder S; S.init(M, DM, F.G, (int)blockIdx.x);
        pg8::EpiF32 E{(float*)(F.ws + WS_MIX), DM};
        pg8::gemm_phase<pg8::EpiF32, pg8::StaticOrder, true>(F.lds, g, S, E);
    } SEAM(4);

    if (IN(5)) { p5_ln1_router(F, args); } SEAM(5);

    if (IN(6)) { p6_positions(F); } SEAM(6);

    if (IN(7)) {
        const int RT = moe_table(F);
        pg8::Gemm g{(const bf16_t*)(F.ws + WS_H1B), (const bf16_t*)(F.ws + WS_WGU), DM, (const int*)(F.ctl + CW_ROWIDX)};
        pg8::MoeOrder<2> S{(const LAS int*)(F.lds + LDS_TBL) + 40, RT, F.G, (int)blockIdx.x};
        pg8::EpiGateUp E{(bf16_t*)(F.ws + WS_ACT)};
        pg8::gemm_phase<pg8::EpiGateUp, pg8::MoeOrder<2>, true, true>(F.lds, g, S, E);
    } SEAM(7);

    if (IN(8)) {
        const int RT = moe_table(F);
        pg8::Gemm g{(const bf16_t*)(F.ws + WS_ACT), (const bf16_t*)(F.ws + WS_WD), DEXP, nullptr};
        pg8::MoeOrder<4> S{(const LAS int*)(F.lds + LDS_TBL) + 40, RT, F.G, (int)blockIdx.x};
        pg8::EpiDown E{(bf16_t*)(F.ws + WS_YS), (const float*)(F.ws + WS_WROW)};
        pg8::gemm_phase<pg8::EpiDown, pg8::MoeOrder<4>, true>(F.lds, g, S, E);
    } SEAM(8);

    if (IN(9)) { p9_ln2(F, args); }
#undef IN
#undef SEAM
}

extern "C" void kernel_launch(void* const* d_in, const int* in_sizes, int n_in, void* d_out, int out_size, void* d_ws, size_t ws_size, hipStream_t stream) {
    static int grid = 0;
    if (grid == 0) {
        if (n_in != 17 || out_size != M * DM || ws_size < WS_END) { fprintf(stderr, "kernel_launch: unexpected shapes (n_in %d out %d ws %zu)\n", n_in, out_size, ws_size); grid = -1; return; }
        int dev = 0, cus = 0, per_cu = 0;
        if (hipGetDevice(&dev) != hipSuccess || hipDeviceGetAttribute(&cus, hipDeviceAttributeMultiprocessorCount, dev) != hipSuccess) { grid = -1; return; }
        if (hipFuncSetAttribute((const void*)fwd_kernel, hipFuncAttributeMaxDynamicSharedMemorySize, LDS_BYTES) != hipSuccess) { fprintf(stderr, "kernel_launch: hipFuncSetAttribute failed\n"); grid = -1; return; }
        if (hipOccupancyMaxActiveBlocksPerMultiprocessor(&per_cu, (const void*)fwd_kernel, NWAVES * 64, LDS_BYTES) != hipSuccess || per_cu < 1)
            fprintf(stderr, "kernel_launch: note: occupancy query reports %d workgroups per CU\n", per_cu);
        (void)hipGetLastError();
        grid = cus;
    }
    if (grid < 0) return;
    (void)hipMemsetAsync((char*)d_ws + WS_CTL, 0, CTL_ZERO_BYTES, stream);
    Args a{};
    for (int i = 0; i < 17; ++i) a.in[i] = (const float*)d_in[i];
    a.out = (float*)d_out; a.ws = (unsigned char*)d_ws;
#if MK_N_LAUNCHES == 1
    a.ph_lo = 0; a.ph_hi = N_PHASES;
    hipLaunchKernelGGL(fwd_kernel, dim3(grid), dim3(NWAVES * 64), LDS_BYTES, stream, a);
#else
    for (int p = 0; p < N_PHASES; ++p) { a.ph_lo = p; a.ph_hi = p + 1; hipLaunchKernelGGL(fwd_kernel, dim3(grid), dim3(NWAVES * 64), LDS_BYTES, stream, a); }
#endif
}
```

```cpp
#include <hip/hip_runtime.h>
#include <hip/hip_bf16.h>
#include <cstdio>
#include <cstdint>
#include <cmath>

#ifndef MK_N_LAUNCHES
#define MK_N_LAUNCHES 1
#endif

constexpr int BATCH = 4, SEQ = 4096, DM = 1024, M = BATCH * SEQ;
constexpr int AW = 512;
constexpr int NIN = 2816;
constexpr int IN_W = 2632, P_OFF = 2120, IK_OFF = 2048, IW_OFF = 2112;
constexpr int NEXP = 32, DEXP = 256;
constexpr int MAXROWS = 40960;
constexpr float LN_EPS = 1e-5f;
constexpr float ALPHA = 1.189207115002721f;
constexpr float LOG2E = 1.4426950408889634f;
constexpr float QSCALE = 0.125f * LOG2E;

constexpr size_t MiB = 1u << 20;
constexpr size_t WS_CTL = 0, CTL_ZERO_BYTES = 1 * MiB;
constexpr size_t WS_IW = 1 * MiB;
constexpr size_t WS_RE = 1 * MiB + 512 * 1024;
constexpr size_t WS_RW = WS_RE + 128 * 1024;
constexpr size_t WS_POS = WS_RW + 128 * 1024;
constexpr size_t WS_WROW = WS_POS + 128 * 1024;
constexpr size_t WS_WRT = 3 * MiB;
constexpr size_t WS_BIAS = 3 * MiB + 256 * 1024;
constexpr size_t WS_WOUT = 4 * MiB;
constexpr size_t WS_WPBD = 6 * MiB;
constexpr size_t WS_WOUT2 = 62 * MiB;
constexpr size_t WS_WGU = 8 * MiB;
constexpr size_t WS_WD = 40 * MiB;
constexpr size_t WS_WIN = 56 * MiB;
constexpr size_t WS_XB = 64 * MiB;
constexpr size_t WS_Q = 96 * MiB;
constexpr size_t WS_K = 112 * MiB, WS_V = 128 * MiB, WS_IQ = 144 * MiB, WS_U = 160 * MiB;
constexpr size_t WS_IK = 176 * MiB;
constexpr size_t WS_MASK = 178 * MiB;
constexpr size_t WS_POOLED = 186 * MiB;
constexpr size_t WS_AP = 202 * MiB;
constexpr size_t WS_MIX = 64 * MiB;
constexpr size_t WS_H1B = 128 * MiB;
constexpr size_t WS_ACT = 160 * MiB;
constexpr size_t WS_YS = 64 * MiB;
constexpr size_t WS_END = 256 * MiB;
constexpr int CW_BAR = 4096  , CW_CNT = 20480, CW_CUR = 20480 + 64, CW_ROWIDX = 24576;
static_assert((CW_ROWIDX + MAXROWS) * 4 <= (int)CTL_ZERO_BYTES, "ctl");

constexpr int RING_BYTES = 131072;
constexpr int SC_RS = 4104;
constexpr int SC_HS = 260;
constexpr int LDS_HIST = 16 * SC_RS * 2;
constexpr int LDS_MST = LDS_HIST + 16 * SC_HS * 4;
constexpr int LDS_WT = LDS_MST + 8192;
constexpr int LDS_BIAS = 139264;
constexpr int LDS_TBL = 156672;
constexpr int LDS_MISC = 158720;
constexpr int LDS_BYTES = 160 * 1024;

#define GAS __attribute__((address_space(1)))
#define LAS __attribute__((address_space(3)))
typedef unsigned short bf16_t;
typedef unsigned v4u __attribute__((ext_vector_type(4)));
typedef unsigned v2u __attribute__((ext_vector_type(2)));
typedef float f32x4 __attribute__((ext_vector_type(4)));
typedef float f32x2 __attribute__((ext_vector_type(2)));
typedef float f32x16 __attribute__((ext_vector_type(16)));
typedef short bf16x8 __attribute__((ext_vector_type(8)));
typedef GAS unsigned gu32;
#define RLX_AGENT __ATOMIC_RELAXED, __HIP_MEMORY_SCOPE_AGENT
#define LADD(p, v) __hip_atomic_fetch_add((p), (v), __ATOMIC_RELAXED, __HIP_MEMORY_SCOPE_WORKGROUP)
#define LDS_WAIT() asm volatile("s_waitcnt lgkmcnt(0)" ::: "memory")
#define VM_WAIT() asm volatile("s_waitcnt vmcnt(0)" ::: "memory")
__device__ __forceinline__ unsigned f2bf(float f) { unsigned u = __builtin_bit_cast(unsigned, f); return (u + 0x7fffu + ((u >> 16) & 1u)) >> 16; }
__device__ __forceinline__ unsigned pk2(float lo, float hi) { return f2bf(lo) | (f2bf(hi) << 16); }
__device__ __forceinline__ float bf2f(unsigned short b) { return __builtin_bit_cast(float, (unsigned)b << 16); }
__device__ __forceinline__ float wave_sum(float v) {
#pragma unroll
    for (int o = 1; o < 64; o <<= 1) v += __shfl_xor(v, o);
    return v;
}

namespace pg8 {
#define PG8_LAS __attribute__((address_space(3)))
constexpr int BM = 256, BK = 64, HALF = 128, HTB = HALF * BK * 2, STAGE_BYTES = 8 * HTB, NXCD = 8, WGM = 8;
__host__ __device__ __forceinline__ int lds_byte(int r, int c) { const int st = (r >> 4) * 2 + (c >> 5), rr = r & 15, cc = c & 31, ob = rr * 64 + cc * 2; return st * 1024 + (ob ^ (((ob >> 9) & 1) << 5)); }
__host__ __device__ __forceinline__ void stage_rc(int b, int& R, int& C) { const int st = b / 1024, sb = b % 1024, swz = sb ^ (((sb >> 9) & 1) << 5); R = (st >> 1) * 16 + swz / 64; C = (st & 1) * 32 + (swz % 64) / 2; }
__host__ __device__ __forceinline__ int perm32(int rho) { const int n = rho >> 4, i = rho & 15; return 8 * (i >> 2) + 4 * n + (i & 3); }
struct Unit { int pm, pn; };
struct Gemm { const bf16_t* A; const bf16_t* Bt; int K; const int* rowidx; int lda; };
struct StaticOrder {
    int nM, nN, nwg, G, c;
    __host__ __device__ void init(int M_, int N_, int G_, int c_) { nM = M_ / BM; nN = N_ / BM; nwg = nM * nN; G = G_; c = c_; }
    __host__ __device__ bool next(int i, Unit& u) const {
        const long L = (long)i * G + c; if (L >= nwg) return false;
        int wgid = (int)L; { const int q = nwg / NXCD, r = nwg % NXCD, xcd = wgid % NXCD, off = wgid / NXCD; wgid = (xcd < r ? xcd * (q + 1) : r * (q + 1) + (xcd - r) * q) + off; }
        const int nig = WGM * nN, gid = wgid / nig, fm = gid * WGM, gsz = (nM - fm) < WGM ? (nM - fm) : WGM;
        u.pm = fm + ((wgid % nig) % gsz); u.pn = (wgid % nig) / gsz; return true;
    }
};
__device__ __forceinline__ unsigned cvt_pk_bf16(float lo, float hi) { unsigned r; asm volatile("v_cvt_pk_bf16_f32 %0, %1, %2" : "=v"(r) : "v"(lo), "v"(hi)); return r; }

template <class Epi, class Sched, bool ALIGN_EPI, bool GATHER = false>
__device__ __forceinline__ void gemm_phase(PG8_LAS unsigned char* lds, const Gemm g, const Sched& S, const Epi& E) {
    const int tid = threadIdx.x, wid = __builtin_amdgcn_readfirstlane(tid >> 6), lane = tid & 63, wr = wid >> 2, wc = wid & 3, fr = lane & 15, fq = lane >> 4;
    const int K = g.K, nt = K / BK;
    int RA[2]; unsigned voffA[2], voffB[2];
#pragma unroll
    for (int i = 0; i < 2; ++i) { int R, C; stage_rc(tid * 16 + i * 8192, R, C); const int Rb = Epi::PERM ? ((R & ~31) + perm32(R & 31)) : R;
        RA[i] = R; voffA[i] = GATHER ? (unsigned)(C * 2) : (unsigned)(R * g.lda + C) * 2u; voffB[i] = (unsigned)(Rb * K + C) * 2u; }
    const size_t kstep = (size_t)(BK * 2);
    const size_t hstep = (size_t)HALF * K * 2;
    const size_t tstep = 2 * hstep;
    const size_t hstepA = (size_t)HALF * g.lda * 2, tstepA = 2 * hstepA;
    const unsigned rowb = (unsigned)g.lda * 2u;
    const unsigned ldsw = (unsigned)wid * 1024u;
    const int aoff = lds_byte(wr * 64 + fr, fq * 8), boff = lds_byte(wc * 32 + fr, fq * 8);
#define PG8_SA(b, h) (((b) * 2 + (h)) * HTB)
#define PG8_SB(b, h) ((4 + (b) * 2 + (h)) * HTB)
#define PG8_STAGE(bufoff, gbase, voff) do { _Pragma("unroll") for (int _i = 0; _i < 2; ++_i) \
        __builtin_amdgcn_global_load_lds((const unsigned*)((const char*)(gbase) + (voff)[_i]), (PG8_LAS unsigned*)(lds + (bufoff) + ldsw + _i * 8192), 16, 0, 0); } while (0)
#define PG8_STAGEA(bufoff, h, NX, kb) do { if constexpr (GATHER) { _Pragma("unroll") for (int _i = 0; _i < 2; ++_i) { const unsigned _o = (NX) ? an[h][_i] : ac[h][_i]; \
            __builtin_amdgcn_global_load_lds((const unsigned*)((const char*)g.A + (size_t)_o + (kb)), (PG8_LAS unsigned*)(lds + (bufoff) + ldsw + _i * 8192), 16, 0, 0); } } \
        else { const char* _b = ((NX) ? nA : cA) + (h) * hstepA + (kb); PG8_STAGE(bufoff, _b, voffA); } } while (0)
#define PG8_LDA(dst, b, h) do { _Pragma("unroll") for (int m = 0; m < 4; ++m) _Pragma("unroll") for (int k = 0; k < 2; ++k) dst[m][k] = *(const PG8_LAS bf16x8*)(lds + PG8_SA(b, h) + aoff + m * 2048 + k * 1024); } while (0)
#define PG8_LDB(dst, b, h) do { _Pragma("unroll") for (int n = 0; n < 2; ++n) _Pragma("unroll") for (int k = 0; k < 2; ++k) dst[n][k] = *(const PG8_LAS bf16x8*)(lds + PG8_SB(b, h) + boff + n * 2048 + k * 1024); } while (0)
#define PG8_MMA(ai, bj, At, Bt) do { __builtin_amdgcn_s_setprio(1); _Pragma("unroll") for (int m = 0; m < 4; ++m) _Pragma("unroll") for (int n = 0; n < 2; ++n) _Pragma("unroll") for (int k = 0; k < 2; ++k) \
        acc[ai][bj][m][n] = __builtin_amdgcn_mfma_f32_16x16x32_bf16(Bt[n][k], At[m][k], acc[ai][bj][m][n], 0, 0, 0); __builtin_amdgcn_s_setprio(0); } while (0)
#define PG8_WAIT_V(n) asm volatile("s_waitcnt vmcnt(" #n ")" ::: "memory")
#define PG8_WAIT_L(n) asm volatile("s_waitcnt lgkmcnt(" #n ")" ::: "memory")
#define PG8_BAR __builtin_amdgcn_s_barrier()
#define PG8_SCHED __builtin_amdgcn_sched_barrier(0)
#define PG8_AROWS(dst, un) do { _Pragma("unroll") for (int _h = 0; _h < 2; ++_h) _Pragma("unroll") for (int _i = 0; _i < 2; ++_i) { \
        const int _r = (un).pm * BM + _h * HALF + RA[_i]; dst[_h][_i] = (unsigned)g.rowidx[_r] * rowb + voffA[_i]; } } while (0)
    Unit cur, nxt; int ui = 0;
    if (!S.next(0, cur)) return;
    f32x4 acc[2][2][4][2];
#pragma unroll
    for (int a = 0; a < 2; ++a)
#pragma unroll
        for (int b = 0; b < 2; ++b)
#pragma unroll
            for (int m = 0; m < 4; ++m)
#pragma unroll
                for (int n = 0; n < 2; ++n) acc[a][b][m][n] = (f32x4){0.f, 0.f, 0.f, 0.f};
    bf16x8 At[4][2], B0[2][2], B1[2][2];
    unsigned ac[2][2], an[2][2];
    if constexpr (GATHER) { PG8_AROWS(ac, cur); }
    const char* cA = (const char*)g.A + (size_t)cur.pm * tstepA; const char* nA = cA;
    const char* cB = (const char*)g.Bt + (size_t)cur.pn * tstep;
    {
        PG8_STAGE(PG8_SB(0, 0), cB, voffB); PG8_STAGE(PG8_SB(0, 1), cB + hstep, voffB); PG8_STAGEA(PG8_SA(0, 0), 0, false, 0); PG8_STAGEA(PG8_SA(0, 1), 1, false, 0);
        if (wr == 1) PG8_BAR;
        PG8_WAIT_V(2); PG8_BAR;
        PG8_STAGE(PG8_SB(1, 0), cB + kstep, voffB); PG8_STAGEA(PG8_SA(1, 0), 0, false, kstep); PG8_STAGE(PG8_SB(1, 1), cB + hstep + kstep, voffB);
        PG8_WAIT_V(6); PG8_BAR;
    }
    for (;;) {
        const bool has_next = S.next(ui + 1, nxt);
        if constexpr (GATHER) { if (has_next) { PG8_AROWS(an, nxt); } else {
#pragma unroll
            for (int h = 0; h < 2; ++h)
#pragma unroll
                for (int i = 0; i < 2; ++i) an[h][i] = ac[h][i]; } }
        nA = has_next ? (const char*)g.A + (size_t)nxt.pm * tstepA : cA;
        const char* nB = has_next ? (const char*)g.Bt + (size_t)nxt.pn * tstep : cB;
        for (int t = 0; t < nt; t += 2) {
            const bool last = (t == nt - 2);
            const size_t kb1 = (size_t)(t + 1) * kstep;
            const size_t kb2 = last ? 0 : (size_t)(t + 2) * kstep, kb3 = kb2 + kstep;
            const char* b2 = last ? nB : cB + (size_t)(t + 2) * kstep; const char* b3 = b2 + kstep;
            PG8_LDB(B0, 0, 0); PG8_LDB(B1, 0, 1); PG8_SCHED; PG8_LDA(At, 0, 0); PG8_STAGEA(PG8_SA(1, 1), 1, false, kb1);
            PG8_WAIT_V(8); PG8_WAIT_L(0); PG8_BAR; PG8_MMA(0, 0, At, B0); PG8_MMA(0, 1, At, B1); PG8_BAR; PG8_SCHED;
            PG8_LDA(At, 0, 1); PG8_STAGE(PG8_SB(0, 0), b2, voffB); PG8_STAGE(PG8_SB(0, 1), b2 + hstep, voffB); PG8_STAGEA(PG8_SA(0, 0), 0, last, kb2);
            PG8_WAIT_V(8); PG8_WAIT_L(0); PG8_BAR; PG8_MMA(1, 0, At, B0); PG8_MMA(1, 1, At, B1); PG8_BAR; PG8_SCHED;
            PG8_LDB(B0, 1, 0); PG8_LDB(B1, 1, 1); PG8_SCHED; PG8_LDA(At, 1, 0); PG8_STAGEA(PG8_SA(0, 1), 1, last, kb2);
            PG8_WAIT_V(8); PG8_WAIT_L(0); PG8_BAR; PG8_MMA(0, 0, At, B0); PG8_MMA(0, 1, At, B1); PG8_BAR; PG8_SCHED;
            PG8_LDA(At, 1, 1); PG8_STAGE(PG8_SB(1, 0), b3, voffB); PG8_STAGE(PG8_SB(1, 1), b3 + hstep, voffB); PG8_STAGEA(PG8_SA(1, 0), 0, last, kb3);
            PG8_WAIT_V(8); PG8_WAIT_L(0); PG8_BAR; PG8_MMA(1, 0, At, B0); PG8_MMA(1, 1, At, B1); PG8_BAR; PG8_SCHED;
        }
        if constexpr (ALIGN_EPI) { if (wr == 0) PG8_BAR; }
        E(acc, cur, wr, wc, fr, fq);
        if (!has_next) break;
#pragma unroll
        for (int a = 0; a < 2; ++a)
#pragma unroll
            for (int b = 0; b < 2; ++b)
#pragma unroll
                for (int m = 0; m < 4; ++m)
#pragma unroll
                    for (int n = 0; n < 2; ++n) acc[a][b][m][n] = (f32x4){0.f, 0.f, 0.f, 0.f};
        cur = nxt; cA = nA; cB = nB; ++ui;
        if constexpr (GATHER) {
#pragma unroll
            for (int h = 0; h < 2; ++h)
#pragma unroll
                for (int i = 0; i < 2; ++i) ac[h][i] = an[h][i]; }
        if constexpr (ALIGN_EPI) { if (wr == 1) PG8_BAR; }
    }
    PG8_WAIT_V(0);
    if constexpr (!ALIGN_EPI) { if (wr == 0) PG8_BAR; }
    PG8_BAR;
#undef PG8_SA
#undef PG8_SB
#undef PG8_STAGE
#undef PG8_STAGEA
#undef PG8_LDA
#undef PG8_LDB
#undef PG8_MMA
#undef PG8_WAIT_V
#undef PG8_WAIT_L
#undef PG8_BAR
#undef PG8_SCHED
#undef PG8_AROWS
}

struct EpiInProj {
    static constexpr bool PERM = true;
    bf16_t* Q; bf16_t* IK; float* IW;
    __device__ __forceinline__ void operator()(const f32x4 (&acc)[2][2][4][2], const Unit& u, int wr, int wc, int fr, int fq) const {
        const int row0 = u.pm * BM + wr * 64 + fr;
        if (u.pn < 10) {
            const int t = u.pn >> 1; bf16_t* base = Q + (size_t)t * ((size_t)M * AW); const float sc = (t == 0) ? QSCALE : 1.f;
            const int col0 = (u.pn & 1) * 256 + wc * 32 + 8 * fq;
#pragma unroll
            for (int ai = 0; ai < 2; ++ai)
#pragma unroll
                for (int m = 0; m < 4; ++m) { bf16_t* rowp = base + (size_t)(row0 + ai * HALF + m * 16) * AW + col0;
#pragma unroll
                    for (int bj = 0; bj < 2; ++bj) { const f32x4 v0 = acc[ai][bj][m][0] * sc, v1 = acc[ai][bj][m][1] * sc;
                        v4u w; w.x = cvt_pk_bf16(v0[0], v0[1]); w.y = cvt_pk_bf16(v0[2], v0[3]); w.z = cvt_pk_bf16(v1[0], v1[1]); w.w = cvt_pk_bf16(v1[2], v1[3]);
                        *(v4u*)(rowp + bj * HALF) = w; } }
        } else {
            if (wc < 2) {
#pragma unroll
                for (int ai = 0; ai < 2; ++ai)
#pragma unroll
                    for (int m = 0; m < 4; ++m) { const f32x4 v0 = acc[ai][0][m][0], v1 = acc[ai][0][m][1];
                        v4u w; w.x = cvt_pk_bf16(v0[0], v0[1]); w.y = cvt_pk_bf16(v0[2], v0[3]); w.z = cvt_pk_bf16(v1[0], v1[1]); w.w = cvt_pk_bf16(v1[2], v1[3]);
                        *(v4u*)(IK + (size_t)(row0 + ai * HALF + m * 16) * 64 + wc * 32 + 8 * fq) = w; }
            } else if (wc == 2 && fq == 0) {
#pragma unroll
                for (int ai = 0; ai < 2; ++ai)
#pragma unroll
                    for (int m = 0; m < 4; ++m) { float* p = IW + (size_t)(row0 + ai * HALF + m * 16) * 8;
                        *(f32x4*)p = acc[ai][0][m][0]; *(f32x4*)(p + 4) = acc[ai][0][m][1]; }
            }
        }
    }
};
struct EpiBf16Plain {
    static constexpr bool PERM = true;
    bf16_t* O; int ldc; int coloff;
    __device__ __forceinline__ void operator()(const f32x4 (&acc)[2][2][4][2], const Unit& u, int wr, int wc, int fr, int fq) const {
        const int row0 = u.pm * BM + wr * 64 + fr, col0 = coloff + u.pn * BM + wc * 32 + 8 * fq;
#pragma unroll
        for (int ai = 0; ai < 2; ++ai)
#pragma unroll
            for (int m = 0; m < 4; ++m) { bf16_t* rowp = O + (size_t)(row0 + ai * HALF + m * 16) * ldc + col0;
#pragma unroll
                for (int bj = 0; bj < 2; ++bj) { const f32x4 v0 = acc[ai][bj][m][0], v1 = acc[ai][bj][m][1];
                    v4u w; w.x = cvt_pk_bf16(v0[0], v0[1]); w.y = cvt_pk_bf16(v0[2], v0[3]); w.z = cvt_pk_bf16(v1[0], v1[1]); w.w = cvt_pk_bf16(v1[2], v1[3]);
                    *(v4u*)(rowp + bj * HALF) = w; } }
    }
};
struct EpiF32 {
    static constexpr bool PERM = false;
    float* O; int ldc;
    __device__ __forceinline__ void operator()(const f32x4 (&acc)[2][2][4][2], const Unit& u, int wr, int wc, int fr, int fq) const {
        const int row0 = u.pm * BM + wr * 64 + fr, col0 = u.pn * BM + wc * 32 + 4 * fq;
#pragma unroll
        for (int ai = 0; ai < 2; ++ai)
#pragma unroll
            for (int m = 0; m < 4; ++m) { float* rowp = O + (size_t)(row0 + ai * HALF + m * 16) * ldc + col0;
#pragma unroll
                for (int bj = 0; bj < 2; ++bj)
#pragma unroll
                    for (int n = 0; n < 2; ++n) *(f32x4*)(rowp + bj * HALF + n * 16) = acc[ai][bj][m][n]; }
    }
};
struct EpiGateUp {
    static constexpr bool PERM = true;
    bf16_t* ACT;
    __device__ __forceinline__ void operator()(const f32x4 (&acc)[2][2][4][2], const Unit& u, int wr, int wc, int fr, int fq) const {
        const int row0 = u.pm * BM + wr * 64 + fr, col0 = (u.pn & 1) * 128 + wc * 32 + 8 * fq;
#pragma unroll
        for (int ai = 0; ai < 2; ++ai)
#pragma unroll
            for (int m = 0; m < 4; ++m) { float o[8];
#pragma unroll
                for (int n = 0; n < 2; ++n)
#pragma unroll
                    for (int e = 0; e < 4; ++e) { const float gt = acc[ai][0][m][n][e], up = acc[ai][1][m][n][e];
                        const float sg = gt * __builtin_amdgcn_rcpf(1.f + __builtin_amdgcn_exp2f(-gt * LOG2E)); o[n * 4 + e] = sg * up; }
                v4u w; w.x = cvt_pk_bf16(o[0], o[1]); w.y = cvt_pk_bf16(o[2], o[3]); w.z = cvt_pk_bf16(o[4], o[5]); w.w = cvt_pk_bf16(o[6], o[7]);
                *(v4u*)(ACT + (size_t)(row0 + ai * HALF + m * 16) * DEXP + col0) = w; }
    }
};
struct EpiDown {
    static constexpr bool PERM = true;
    bf16_t* YS; const float* wrow;
    __device__ __forceinline__ void operator()(const f32x4 (&acc)[2][2][4][2], const Unit& u, int wr, int wc, int fr, int fq) const {
        const int row0 = u.pm * BM + wr * 64 + fr, col0 = (u.pn & 3) * 256 + wc * 32 + 8 * fq;
#pragma unroll
        for (int ai = 0; ai < 2; ++ai)
#pragma unroll
            for (int m = 0; m < 4; ++m) { const int row = row0 + ai * HALF + m * 16; const float sc = wrow[row]; bf16_t* rowp = YS + (size_t)row * DM + col0;
#pragma unroll
                for (int bj = 0; bj < 2; ++bj) { const f32x4 v0 = acc[ai][bj][m][0] * sc, v1 = acc[ai][bj][m][1] * sc;
                    v4u w; w.x = cvt_pk_bf16(v0[0], v0[1]); w.y = cvt_pk_bf16(v0[2], v0[3]); w.z = cvt_pk_bf16(v1[0], v1[1]); w.w = cvt_pk_bf16(v1[2], v1[3]);
                    *(v4u*)(rowp + bj * HALF) = w; } }
    }
};
struct OneUnit { int pm, pn; bool has; __device__ __forceinline__ bool next(int i, Unit& u) const { if (i != 0 || !has) return false; u.pm = pm; u.pn = pn; return true; } };
template <int NC> struct MoeOrder {
    const LAS int* tile_e; int RT, G, c;
    __device__ __forceinline__ bool next(int i, Unit& u) const {
        const int L = i * G + c; if (L >= RT * NC) return false;
        const int rt = L / NC, ct = L % NC; u.pm = rt; u.pn = tile_e[rt] * NC + ct; return true;
    }
};
}

namespace attn_body {
using bf16 = __hip_bfloat16;
using s16x4 = __attribute__((ext_vector_type(4))) short;
using u32x4 = __attribute__((ext_vector_type(4))) unsigned;
constexpr int NHEAD = 8, D = 64, KP = NHEAD * D  , OP = 1024  ;
constexpr int NW = 8, QBLK = 32, QB = QBLK * NW, KVBLK = 64, NQB = SEQ / QB;
__device__ __forceinline__ int crow(int r, int hi) { return (r & 3) + 8 * (r >> 2) + 4 * hi; }
#define SBAR() __builtin_amdgcn_sched_barrier(0)
constexpr int NSLOT = 3, SLOTB = 8192;
constexpr int LDS_K = 0, LDS_V = NSLOT * SLOTB, LDS_WS = 2 * NSLOT * SLOTB, LDS_OST = LDS_WS + NW * 64 * 4, ATT_LDS_BYTES = LDS_OST + NW * 4096;
__device__ __forceinline__ void glds16(const void* gsrc, unsigned lds_dst) { unsigned keep;
    asm volatile("s_mov_b32 %0, m0\n\ts_mov_b32 m0, %2\n\ts_nop 0\n\tglobal_load_lds_dwordx4 %1, off\n\ts_mov_b32 m0, %0" : "=&s"(keep) : "v"(gsrc), "s"(lds_dst) : "memory"); }
__device__ __forceinline__ float max3f(float a, float b, float c) { float r; asm("v_max3_f32 %0, %1, %2, %3" : "=v"(r) : "v"(a), "v"(b), "v"(c)); return r; }
__device__ __forceinline__ float max2f(float a, float b) { float r; asm("v_max_f32_e32 %0, %1, %2" : "=v"(r) : "v"(a), "v"(b)); return r; }
__device__ __forceinline__ float fadd_s(float a, float b) { float r; asm("v_add_f32_e32 %0, %1, %2" : "=v"(r) : "v"(a), "v"(b)); return r; }
__device__ __forceinline__ float fsub_s(float a, float b) { float r; asm("v_sub_f32_e32 %0, %1, %2" : "=v"(r) : "v"(a), "v"(b)); return r; }
typedef float f32x2_t __attribute__((ext_vector_type(2))); typedef __bf16 bf16x2_t __attribute__((ext_vector_type(2)));
__device__ __forceinline__ unsigned cvtpk_s(float lo, float hi) { f32x2_t v = {lo, hi}; bf16x2_t b = __builtin_convertvector(v, bf16x2_t); return __builtin_bit_cast(unsigned, b); }
#define WAIT_BAR(N) asm volatile("s_waitcnt vmcnt(" #N ") lgkmcnt(0)\n\ts_barrier" ::: "memory")
__device__ __forceinline__ void qkt(f32x16& p0, f32x16& p1, const char* Kslot, const bf16x8* qr, int r32, int hi) {
    const char* kb = Kslot + hi * 1024 + r32 * 16;
#pragma unroll
    for (int d0 = 0; d0 < 4; ++d0) {
        const bf16x8 b0 = *reinterpret_cast<const bf16x8*>(kb + d0 * 2048);
        const bf16x8 b1 = *reinterpret_cast<const bf16x8*>(kb + d0 * 2048 + 512);
        if (d0 == 0) { p0 = __builtin_amdgcn_mfma_f32_32x32x16_bf16(b0, qr[0], f32x16{}, 0, 0, 0); p1 = __builtin_amdgcn_mfma_f32_32x32x16_bf16(b1, qr[0], f32x16{}, 0, 0, 0); }
        else { p0 = __builtin_amdgcn_mfma_f32_32x32x16_bf16(b0, qr[d0], p0, 0, 0, 0); p1 = __builtin_amdgcn_mfma_f32_32x32x16_bf16(b1, qr[d0], p1, 0, 0, 0); } }
}
typedef __attribute__((address_space(3))) const char* lds_cptr;
typedef short v4i16_t __attribute__((ext_vector_type(4)));
__device__ __forceinline__ void kload8(bf16x8* kf, lds_cptr kp) {
    kf[0] = *(const __attribute__((address_space(3))) bf16x8*)(kp);        kf[1] = *(const __attribute__((address_space(3))) bf16x8*)(kp + 512);
    kf[2] = *(const __attribute__((address_space(3))) bf16x8*)(kp + 2048); kf[3] = *(const __attribute__((address_space(3))) bf16x8*)(kp + 2560);
    kf[4] = *(const __attribute__((address_space(3))) bf16x8*)(kp + 4096); kf[5] = *(const __attribute__((address_space(3))) bf16x8*)(kp + 4608);
    kf[6] = *(const __attribute__((address_space(3))) bf16x8*)(kp + 6144); kf[7] = *(const __attribute__((address_space(3))) bf16x8*)(kp + 6656);
}
__device__ __forceinline__ void kload2(bf16x8* kf, lds_cptr kp, int j) { kf[2 * j] = *(const __attribute__((address_space(3))) bf16x8*)(kp + j * 2048); kf[2 * j + 1] = *(const __attribute__((address_space(3))) bf16x8*)(kp + j * 2048 + 512); }
__device__ __forceinline__ s16x4 vtr(lds_cptr p) { return __builtin_bit_cast(s16x4, __builtin_amdgcn_ds_read_tr16_b64_v4i16((__attribute__((address_space(3))) v4i16_t*)p)); }
__device__ __forceinline__ float rowmax(const f32x16& p0, const f32x16& p1) {
    float a = max3f(p0[0], p0[1], p1[0]), b = max3f(p0[2], p0[3], p1[1]); a = max3f(a, p1[2], p1[3]);
#pragma unroll
    for (int r = 4; r < 16; r += 4) { a = max3f(a, p0[r], p0[r + 1]); b = max3f(b, p0[r + 2], p0[r + 3]); a = max3f(a, p1[r], p1[r + 1]); b = max3f(b, p1[r + 2], p1[r + 3]); }
    const float m = max2f(a, b);
    auto rr = __builtin_amdgcn_permlane32_swap(__float_as_uint(m), __float_as_uint(m), false, false);
    return max2f(__uint_as_float(rr[0]), __uint_as_float(rr[1]));
}
__device__ __forceinline__ void pv(f32x16* o, int vb, bf16x8 pa0, bf16x8 pa1, bf16x8 pa2, bf16x8 pa3) {
#pragma unroll
    for (int d0 = 0; d0 < 2; ++d0) { s16x4 lo[4], hi[4];
#pragma unroll
        for (int ks = 0; ks < 4; ++ks) {
            asm volatile("ds_read_b64_tr_b16 %0,%1 offset:%c2" : "=&v"(lo[ks]) : "v"(vb), "i"(d0 * 4096 + ks * 1024) : "memory");
            asm volatile("ds_read_b64_tr_b16 %0,%1 offset:%c2" : "=&v"(hi[ks]) : "v"(vb), "i"(d0 * 4096 + ks * 1024 + 512) : "memory"); }
        asm volatile("s_waitcnt lgkmcnt(0)" ::: "memory"); SBAR();
#define PK(k) (bf16x8){lo[k][0], lo[k][1], lo[k][2], lo[k][3], hi[k][0], hi[k][1], hi[k][2], hi[k][3]}
        o[d0] = __builtin_amdgcn_mfma_f32_32x32x16_bf16(pa0, PK(0), o[d0], 0, 0, 0);
        o[d0] = __builtin_amdgcn_mfma_f32_32x32x16_bf16(pa1, PK(1), o[d0], 0, 0, 0);
        o[d0] = __builtin_amdgcn_mfma_f32_32x32x16_bf16(pa2, PK(2), o[d0], 0, 0, 0);
        o[d0] = __builtin_amdgcn_mfma_f32_32x32x16_bf16(pa3, PK(3), o[d0], 0, 0, 0);
#undef PK
    }
}
__device__ __forceinline__ float pmask(float p, unsigned mw, int r) { const int b = (r & 3) + 8 * (r >> 2); return __uint_as_float(__float_as_uint(p) & (unsigned)__builtin_amdgcn_sbfe((int)mw, b, 1)); }
__device__ __forceinline__ void xbias(f32x16& p0, f32x16& p1, const LAS float* tb) {
#pragma unroll
    for (int g = 0; g < 4; ++g) {
#pragma unroll
        for (int r = 4 * g; r < 4 * g + 4; ++r) { const int b = (r & 3) + 8 * (r >> 2); p0[r] += tb[b]; p1[r] += tb[b + 32]; }
        asm volatile("" : "+v"(p0), "+v"(p1) :: "memory"); }
}

template <int THRL> __device__ __forceinline__ void attn_unit(int b, int h, int qb, const bf16* Q, const bf16* __restrict__ K, const bf16* __restrict__ V, bf16* O, const unsigned* MASKQ, const LAS float* btab, char* shm) {
    const int tid = threadIdx.x, lane = tid & 63, r32 = lane & 31, hi = lane >> 5; const int wid = __builtin_amdgcn_readfirstlane(tid >> 6);
    const long rowbase = (long)b * SEQ; const int q0 = qb * QB;
    const bf16* Qw = Q + (rowbase + q0 + wid * QBLK) * KP + h * D;
    const bf16 *Kh = K + rowbase * KP + h * D, *Vh = V + rowbase * KP + h * D;
    const unsigned lds0 = (unsigned)(uintptr_t)shm;
    float* wsf = (float*)(shm + LDS_WS) + wid * 64;
    const bf16* ksrc = Kh + (long)lane * KP + wid * 8;
    const bf16* vsrc = Vh + (long)(16 * (wid & 3) + (lane >> 2)) * KP + (wid >> 2) * 32 + (lane & 3) * 8;
    const unsigned kdst = lds0 + LDS_K + wid * 1024, vdst = lds0 + LDS_V + wid * 1024;
#define DMA_K(t, slot) glds16(ksrc + (long)(t) * KVBLK * KP, (unsigned)__builtin_amdgcn_readfirstlane(kdst + (slot)))
#define DMA_V(t, slot) glds16(vsrc + (long)(t) * KVBLK * KP, (unsigned)__builtin_amdgcn_readfirstlane(vdst + (slot)))
    const int vb0 = (int)(lds0 + LDS_V) + ((lane >> 4) & 1) * 32 + (lane & 3) * 8 + (4 * hi + ((lane & 15) >> 2)) * 64;
    const char* Kbase = shm + LDS_K; bf16x8 kf[8];
    const lds_cptr shm3 = (lds_cptr)shm; const lds_cptr kp0 = shm3 + LDS_K + hi * 1024 + r32 * 16; const lds_cptr vp0 = shm3 + LDS_V + ((lane >> 4) & 1) * 32 + (lane & 3) * 8 + (4 * hi + ((lane & 15) >> 2)) * 64;
    const int NT = (q0 + QB) / KVBLK;
    const int qrel = wid * QBLK + r32;
    const unsigned char* mbase = (const unsigned char*)(MASKQ + (size_t)(rowbase + q0) * 128); const unsigned moff = (unsigned)qrel * 512u;
#define LDM(t) (*(const v2u*)(mbase + (size_t)(8 * (t)) + moff))
    v2u mwc = LDM(0); mwc.x >>= 4 * hi; mwc.y >>= 4 * hi;
    DMA_K(0, 0); DMA_V(0, 0); DMA_K(1, SLOTB);
    bf16x8 qr[4];
#pragma unroll
    for (int d0 = 0; d0 < 4; ++d0) qr[d0] = *reinterpret_cast<const bf16x8*>(&Qw[(long)r32 * KP + d0 * 16 + hi * 8]);
    float mhat = 0.f, l_reg = 0.f; f32x16 o[2]; o[0] = f32x16{}; o[1] = f32x16{};
    const int bidx0 = 4 * hi - (q0 + qrel) + 448;
#define XMB(P0, P1, t) do { if ((t) >= NT - 7) xbias(P0, P1, btab + (bidx0 + 64 * (t))); } while (0)
    bool resc = false;
#define START(P0, P1) do { const float rm = rowmax(P0, P1); resc = false; \
    { const float dl = rm; mhat = fadd_s(mhat, dl); \
      _Pragma("unroll") for (int r = 0; r < 16; ++r) { P0[r] = fsub_s(P0[r], dl); P1[r] = fsub_s(P1[r], dl); } } \
    _Pragma("unroll") for (int r = 0; r < 16; ++r) P0[r] = pmask(__builtin_amdgcn_exp2f(P0[r]), mwc.x, r); } while (0)
#define RESC() do { if (resc) { asm volatile("s_waitcnt lgkmcnt(0)" ::: "memory"); \
      _Pragma("unroll") for (int d_ = 0; d_ < 2; ++d_) _Pragma("unroll") for (int r = 0; r < 16; ++r) o[d_][r] *= wsf[crow(r, hi)]; } } while (0)
    f32x16 pA0, pA1, pB0, pB1;
    int sl_prev = 0, sl_cur = 0, sl_next = SLOTB;
#define ROT() do { sl_prev = sl_cur; sl_cur = sl_next; sl_next = (sl_next == (NSLOT - 1) * SLOTB) ? 0 : sl_next + SLOTB; } while (0)
    DMA_K(2, 2 * SLOTB);
    WAIT_BAR(3);
    qkt(pA0, pA1, Kbase, qr, r32, hi); asm volatile("s_nop 15\n\ts_nop 7" : "+v"(pA0), "+v"(pA1)); XMB(pA0, pA1, 0);
    START(pA0, pA1);
    _Pragma("unroll") for (int r = 0; r < 16; ++r) pA1[r] = pmask(__builtin_amdgcn_exp2f(pA1[r]), mwc.y, r);

    WAIT_BAR(0);
    DMA_K(3, 0); DMA_V(1, SLOTB);
    ROT();
    kload8(kf, kp0 + sl_cur);
    WAIT_BAR(2);
    s16x4 vlo[8], vhi[8]; u32x4 pw0, pw1, pw2, pw3;
#define PKW(P, B) cvtpk_s(P[B], P[B + 1])
#define PAF(k) __builtin_bit_cast(bf16x8, pw##k)
#define VFR(i) (bf16x8){vlo[i][0], vlo[i][1], vlo[i][2], vlo[i][3], vhi[i][0], vhi[i][1], vhi[i][2], vhi[i][3]}
#define PIN(x) asm volatile("" : "+v"(x))
#define MX3(a, b, c) __builtin_fmaxf(__builtin_fmaxf((a), (b)), (c))
#define GAPA(MF, A0, A1, A2, A3, W0, W1, PW) do { MF; sacc += A0; sacc += A1; sacc += A2; sacc += A3; PIN(sacc); W0; W1; PIN(PW); SBAR(); } while (0)
#define EX(v) __builtin_amdgcn_exp2f(v)
#define GAPB(MF, X, B, MW) do { MF; X[B] = pmask(EX(X[B] - mhat), MW, B); X[B + 1] = pmask(EX(X[B + 1] - mhat), MW, B + 1); X[B + 2] = pmask(EX(X[B + 2] - mhat), MW, B + 2); X[B + 3] = pmask(EX(X[B + 3] - mhat), MW, B + 3); PIN(X); SBAR(); } while (0)
#define VRD(i) do { vlo[i] = vtr(vp_ + (((i) >> 2) * 4096 + ((i) & 3) * 1024)); vhi[i] = vtr(vp_ + (((i) >> 2) * 4096 + ((i) & 3) * 1024 + 512)); } while (0)
#define KRD(G, j) do { if (G) { kload2(kf, kp0 + sl_next, j); SBAR(); } } while (0)
#define STEP(C0, C1, P0, P1, t, GK, GV, GL) do { SBAR(); \
    const lds_cptr vp_ = vp0 + sl_prev; \
    mwc = LDM(t); \
    VRD(0); SBAR(); float sacc = (P0[0] + P0[1]); \
    GAPA(C0 = __builtin_amdgcn_mfma_f32_32x32x16_bf16(kf[0], qr[0], f32x16{}, 0, 0, 0), P0[2], P0[3], P0[4], P0[5],     pw0[0] = PKW(P0, 0), pw0[1] = PKW(P0, 2), pw0); \
    VRD(4); SBAR(); GAPA(C1 = __builtin_amdgcn_mfma_f32_32x32x16_bf16(kf[1], qr[0], f32x16{}, 0, 0, 0), P0[6], P0[7], P0[8], P0[9],     pw0[2] = PKW(P0, 4), pw0[3] = PKW(P0, 6), pw0); \
    VRD(1); SBAR(); GAPA(C0 = __builtin_amdgcn_mfma_f32_32x32x16_bf16(kf[2], qr[1], C0, 0, 0, 0),   P0[10], P0[11], P0[12], P0[13], pw1[0] = PKW(P0, 8), pw1[1] = PKW(P0, 10), pw1); \
    VRD(5); SBAR(); GAPA(C1 = __builtin_amdgcn_mfma_f32_32x32x16_bf16(kf[3], qr[1], C1, 0, 0, 0),   P0[14], P0[15], P1[0], P1[1],   pw1[2] = PKW(P0, 12), pw1[3] = PKW(P0, 14), pw1); \
    VRD(2); SBAR(); GAPA(C0 = __builtin_amdgcn_mfma_f32_32x32x16_bf16(kf[4], qr[2], C0, 0, 0, 0),   P1[2], P1[3], P1[4], P1[5],     pw2[0] = PKW(P1, 0), pw2[1] = PKW(P1, 2), pw2); \
    VRD(6); SBAR(); GAPA(C1 = __builtin_amdgcn_mfma_f32_32x32x16_bf16(kf[5], qr[2], C1, 0, 0, 0),   P1[6], P1[7], P1[8], P1[9],     pw2[2] = PKW(P1, 4), pw2[3] = PKW(P1, 6), pw2); \
    VRD(3); SBAR(); GAPA(C0 = __builtin_amdgcn_mfma_f32_32x32x16_bf16(kf[6], qr[3], C0, 0, 0, 0),   P1[10], P1[11], P1[12], P1[13], pw3[0] = PKW(P1, 8), pw3[1] = PKW(P1, 10), pw3); \
    VRD(7); SBAR(); GAPA(C1 = __builtin_amdgcn_mfma_f32_32x32x16_bf16(kf[7], qr[3], C1, 0, 0, 0),   P1[14], P1[15], 0.f, 0.f,       pw3[2] = PKW(P1, 12), pw3[3] = PKW(P1, 14), pw3); \
    l_reg += sacc; \
    mwc.x >>= 4 * hi; mwc.y >>= 4 * hi; asm volatile("" : "+v"(mwc.x), "+v"(mwc.y));   \
    if (GK) { DMA_K((t) + 3, sl_cur); } if (GV) { DMA_V((t) + 1, sl_next); } \
    XMASKB(C0, C1, t); \
    { float a = MX3(C0[0], C0[1], C1[0]), b = MX3(C0[2], C0[3], C1[1]); a = MX3(a, C1[2], C1[3]); \
      _Pragma("unroll") for (int r = 4; r < 16; r += 4) { a = MX3(a, C0[r], C0[r + 1]); b = MX3(b, C0[r + 2], C0[r + 3]); a = MX3(a, C1[r], C1[r + 1]); b = MX3(b, C1[r + 2], C1[r + 3]); } \
      float rm = __builtin_fmaxf(a, b); { auto rr = __builtin_amdgcn_permlane32_swap(__float_as_uint(rm), __float_as_uint(rm), false, false); rm = __builtin_fmaxf(__uint_as_float(rr[0]), __uint_as_float(rr[1])); } \
      resc = false; rm -= mhat; \
      if (__builtin_expect(__any(rm > (float)THRL), 0)) { const float dl = __builtin_fmaxf(rm, 0.f); mhat += dl; \
        const float f = __builtin_amdgcn_exp2f(-dl); l_reg *= f; if (hi == 0) wsf[r32] = f; resc = true; } } \
    SBAR(); \
    GAPB(o[0] = __builtin_amdgcn_mfma_f32_32x32x16_bf16(PAF(0), VFR(0), o[0], 0, 0, 0), C0, 0, mwc.x); \
    GAPB(o[1] = __builtin_amdgcn_mfma_f32_32x32x16_bf16(PAF(0), VFR(4), o[1], 0, 0, 0), C0, 4, mwc.x); \
    KRD(GL, 0); GAPB(o[0] = __builtin_amdgcn_mfma_f32_32x32x16_bf16(PAF(1), VFR(1), o[0], 0, 0, 0), C0, 8, mwc.x); \
    KRD(GL, 1); GAPB(o[1] = __builtin_amdgcn_mfma_f32_32x32x16_bf16(PAF(1), VFR(5), o[1], 0, 0, 0), C0, 12, mwc.x); \
    KRD(GL, 2); GAPB(o[0] = __builtin_amdgcn_mfma_f32_32x32x16_bf16(PAF(2), VFR(2), o[0], 0, 0, 0), C1, 0, mwc.y); \
    KRD(GL, 3); GAPB(o[1] = __builtin_amdgcn_mfma_f32_32x32x16_bf16(PAF(2), VFR(6), o[1], 0, 0, 0), C1, 4, mwc.y); \
    GAPB(o[0] = __builtin_amdgcn_mfma_f32_32x32x16_bf16(PAF(3), VFR(3), o[0], 0, 0, 0), C1, 8, mwc.y); \
    GAPB(o[1] = __builtin_amdgcn_mfma_f32_32x32x16_bf16(PAF(3), VFR(7), o[1], 0, 0, 0), C1, 12, mwc.y); \
    } while (0)
    int t = 1;
#define XMASKB(P0, P1, t) do { } while (0)
    for (; t + 7 < NT; t += 2) {
        STEP(pB0, pB1, pA0, pA1, t, true, true, true);     WAIT_BAR(2); RESC(); ROT();
        STEP(pA0, pA1, pB0, pB1, t + 1, true, true, true); WAIT_BAR(2); RESC(); ROT();
    }
#undef XMASKB
#define XMASKB(P0, P1, t) XMB(P0, P1, t)
#define ENDW(tt) do { if ((tt) + 3 < NT) { WAIT_BAR(2); } else if ((tt) + 2 < NT) { WAIT_BAR(1); } else { WAIT_BAR(0); } } while (0)
    for (; t + 1 < NT; t += 2) {
        STEP(pB0, pB1, pA0, pA1, t, (t + 3 < NT), (t + 1 < NT), (t + 1 < NT));         ENDW(t);     RESC(); ROT();
        STEP(pA0, pA1, pB0, pB1, t + 1, (t + 4 < NT), (t + 2 < NT), (t + 2 < NT));     ENDW(t + 1); RESC(); ROT();
    }
    STEP(pB0, pB1, pA0, pA1, NT - 1, false, false, false); RESC();
    { float sacc = pB0[0] + pB0[1]; _Pragma("unroll") for (int r = 2; r < 16; ++r) sacc += pB0[r]; _Pragma("unroll") for (int r = 0; r < 16; ++r) sacc += pB1[r]; l_reg += sacc;
      pw0 = (u32x4){PKW(pB0, 0), PKW(pB0, 2), PKW(pB0, 4), PKW(pB0, 6)}; pw1 = (u32x4){PKW(pB0, 8), PKW(pB0, 10), PKW(pB0, 12), PKW(pB0, 14)}; pw2 = (u32x4){PKW(pB1, 0), PKW(pB1, 2), PKW(pB1, 4), PKW(pB1, 6)}; pw3 = (u32x4){PKW(pB1, 8), PKW(pB1, 10), PKW(pB1, 12), PKW(pB1, 14)};
      SBAR(); pv(o, vb0 + sl_cur, PAF(0), PAF(1), PAF(2), PAF(3)); }
#undef XMASKB
#undef PKW
#undef PAF
#undef VFR
#undef PIN
#undef MX3
#undef GAPA
#undef GAPB
#undef EX
#undef VRD
#undef KRD
#undef STEP
#undef ENDW
    { auto rr = __builtin_amdgcn_permlane32_swap(__float_as_uint(l_reg), __float_as_uint(l_reg), false, false); l_reg = __uint_as_float(rr[0]) + __uint_as_float(rr[1]); }
    if (hi == 0) wsf[32 + r32] = l_reg; asm volatile("s_waitcnt lgkmcnt(0)" ::: "memory");
    float rli[16];
#pragma unroll
    for (int r = 0; r < 16; ++r) rli[r] = __builtin_amdgcn_rcpf(wsf[32 + crow(r, hi)]);
    bf16* Ow = O + (rowbase + q0 + wid * QBLK) * OP + h * D;
    { bf16* stg = (bf16*)(shm + LDS_OST) + wid * 2048;
#pragma unroll
      for (int r = 0; r < 16; ++r) { const int orow = crow(r, hi);
#pragma unroll
          for (int d0 = 0; d0 < 2; ++d0) stg[orow * 64 + d0 * 32 + r32] = __float2bfloat16(o[d0][r] * rli[r]); }
      asm volatile("s_waitcnt lgkmcnt(0)" ::: "memory");
#pragma unroll
      for (int i = 0; i < 4; ++i) { const int row = i * 8 + (lane >> 3), ch = lane & 7; const u32x4 v = *(const u32x4*)(stg + row * 64 + ch * 8); *(u32x4*)(Ow + (long)row * OP + ch * 8) = v; } }
    asm volatile("s_waitcnt lgkmcnt(0)\n\ts_barrier" ::: "memory");
#undef DMA_K
#undef DMA_V
#undef XMB
#undef LDM
#undef START
#undef RESC
#undef ROT
}
#undef SBAR
#undef WAIT_BAR
}

#define XB_TMO      128
#define XB_XCNT(j)  (256  + 64 * (j))
#define XB_XSUB(j)  (1280 + 64 * (j))
#define XB_XGEN(j)  (2304 + 64 * (j))
#define XB_TOP      3328
#define XB_TOPGEN   3392
#define XCD_BAR_WORDS 3456
#define XB_SPIN_CAP (1u << 18)
__device__ __forceinline__ unsigned xb_ld(unsigned* p)              { return __hip_atomic_load(p, __ATOMIC_RELAXED, __HIP_MEMORY_SCOPE_AGENT); }
__device__ __forceinline__ unsigned xb_add(unsigned* p, unsigned v) { return __hip_atomic_fetch_add(p, v, __ATOMIC_RELAXED, __HIP_MEMORY_SCOPE_AGENT); }
__device__ __forceinline__ unsigned xb_xcc_id() { return (unsigned)__builtin_amdgcn_s_getreg((3 << 11) | 20) & 0xFu; }
#define XB_SPIN(cond, bar) do { unsigned _sp = 0; while (cond) { __builtin_amdgcn_s_sleep(1); \
    if ((++_sp & 255u) == 0u) { if (xb_ld(&(bar)[XB_TMO])) break; if (_sp > XB_SPIN_CAP) { atomicAdd(&(bar)[XB_TMO], 1u); break; } } } } while (0)
struct XcdBarrier { unsigned* bar; unsigned x; volatile LAS unsigned* st; };
__device__ __forceinline__ XcdBarrier xcd_barrier_post(unsigned* bar, volatile LAS unsigned* st) {
    XcdBarrier b; b.bar = bar; b.x = xb_xcc_id(); b.st = st;
    if (threadIdx.x == 0) (void)xb_add(&bar[XB_XCNT(b.x)], 1u);
    return b;
}
__device__ __forceinline__ void xcd_barrier_complete(unsigned* bar, unsigned x, unsigned& nloc, unsigned& nx) {
    const unsigned G = gridDim.x * gridDim.y * gridDim.z;
    unsigned sum, cnt, mine, sp = 0u;
    for (;;) {
        sum = 0u; cnt = 0u; mine = 0u;
#pragma unroll
        for (unsigned j = 0; j < 16; ++j) { const unsigned c = xb_ld(&bar[XB_XCNT(j)]); sum += c; cnt += (c > 0u) ? 1u : 0u; mine = (j == x) ? c : mine; }
        if (sum == G) break;
        __builtin_amdgcn_s_sleep(1);
        if ((++sp & 255u) == 0u) { if (xb_ld(&bar[XB_TMO])) break; if (sp > XB_SPIN_CAP) { atomicAdd(&bar[XB_TMO], 1u); break; } }
    }
    nloc = mine > 0u ? mine : 1u; nx = cnt > 0u ? cnt : 1u;
}
__device__ __forceinline__ void xcd_barrier(const XcdBarrier& b) {
    asm volatile("s_waitcnt vmcnt(0)" ::: "memory");
    __syncthreads();
    if (threadIdx.x == 0) {
        unsigned* bar = b.bar;
        __builtin_amdgcn_s_waitcnt(0);
        unsigned nloc = b.st[0], nx = b.st[1];
        if (nloc == 0u) { xcd_barrier_complete(bar, b.x, nloc, nx); b.st[0] = nloc; b.st[1] = nx; }
        const unsigned old = xb_add(&bar[XB_XSUB(b.x)], 1u);
        const unsigned gen = old / nloc;
        if (old + 1u == (gen + 1u) * nloc) {
            __builtin_amdgcn_fence(__ATOMIC_RELEASE, "agent");
            asm volatile("s_waitcnt vmcnt(0)" ::: "memory");
            const unsigned og = xb_add(&bar[XB_TOP], 1u);
            const unsigned tg = og / nx;
            if (og + 1u == (tg + 1u) * nx) xb_add(&bar[XB_TOPGEN], 1u);
            else XB_SPIN(xb_ld(&bar[XB_TOPGEN]) == tg, bar);
            __builtin_amdgcn_fence(__ATOMIC_ACQUIRE, "agent");
            xb_add(&bar[XB_XGEN(b.x)], 1u);
            asm volatile("s_waitcnt vmcnt(0)" ::: "memory");
        } else {
            XB_SPIN(xb_ld(&bar[XB_XGEN(b.x)]) == gen, bar);
            __builtin_amdgcn_fence(__ATOMIC_ACQUIRE, "agent");
            asm volatile("s_waitcnt vmcnt(0)" ::: "memory");
        }
    }
    __syncthreads();
}

constexpr int NWAVES = 8;
struct Args { const float* in[17]; float* out; unsigned char* ws; int ph_lo, ph_hi, bar_region, pad; };
__device__ __forceinline__ const float* inp(int k) { return ((const float* const __attribute__((address_space(4)))*)__builtin_amdgcn_kernarg_segment_ptr())[k]; }
struct Frame {
    LAS unsigned char* lds;
    gu32* ctl;
    unsigned char* ws;
    int tid, lane, wave, vcu, G;
    float* out;
};

template <class SrcCol, class DstRow>
__device__ __forceinline__ void p0_transpose_item(const float* W, int K, int ldN, bf16_t* WT, LAS float* scr, int k0, int n0, int lane, SrcCol srccol, DstRow dstrow) {
    const int sc = srccol(n0 + (lane & 31));
    float tv[32]; const float* wp = W + (size_t)(k0 + (lane >> 5)) * ldN + (sc >= 0 ? sc : 0);
#pragma unroll
    for (int i = 0; i < 32; ++i) tv[i] = wp[(size_t)(2 * i) * ldN];
#pragma unroll
    for (int i = 0; i < 32; ++i) { const int kk = 2 * i + (lane >> 5); scr[kk * 33 + (lane & 31)] = sc >= 0 ? tv[i] : 0.f; }
    LDS_WAIT(); asm volatile("" ::: "memory");
    const int c = lane & 7;
#pragma unroll
    for (int j = 0; j < 4; ++j) { const int n = (lane >> 3) + 8 * j; const LAS float* s = scr + (8 * c) * 33 + n;
        v4u o; o.x = pk2(s[0 * 33], s[1 * 33]); o.y = pk2(s[2 * 33], s[3 * 33]); o.z = pk2(s[4 * 33], s[5 * 33]); o.w = pk2(s[6 * 33], s[7 * 33]);
        *(GAS v4u*)(WT + (size_t)dstrow(n0 + n) * K + k0 + 8 * c) = o; }
    LDS_WAIT(); asm volatile("" ::: "memory");
}
__device__ __forceinline__ int rel_bucket_dev(int n) {
    if (n < 16) return n;
    int v = 16 + (int)(logf((float)n / 16.f) / logf(8.f) * 16.f);
    return v < 31 ? v : 31;
}

__device__ __forceinline__ void p0_prologue(Frame& F, const Args& A) {
    const float* x = inp(0); const float* w_in = inp(1); const float* w_pool = inp(2); const float* pool_scale = inp(3); const float* w_out = inp(4);
    const float* rel_bias = inp(5); const float* w_r1 = inp(8); const float* w_r2 = inp(10); const float* w_gate = inp(12); const float* w_up = inp(13); const float* w_down = inp(14);
    bf16_t* WIN = (bf16_t*)(F.ws + WS_WIN); bf16_t* WOUT = (bf16_t*)(F.ws + WS_WOUT); bf16_t* WOUT2 = (bf16_t*)(F.ws + WS_WOUT2); bf16_t* WPBD = (bf16_t*)(F.ws + WS_WPBD);
    bf16_t* WGU = (bf16_t*)(F.ws + WS_WGU); bf16_t* WD = (bf16_t*)(F.ws + WS_WD); bf16_t* XB = (bf16_t*)(F.ws + WS_XB);
    bf16_t* WRT = (bf16_t*)(F.ws + WS_WRT); float* BT = (float*)(F.ws + WS_BIAS);
    LAS float* scr = (LAS float*)(F.lds + F.wave * 16384);
    const int gw = F.vcu * NWAVES + F.wave, NGW = F.G * NWAVES;
    constexpr int I_IN = 16 * (NIN / 32), I_OUT = 16 * 32, I_GU = 32 * 2 * 16 * 8, I_D = 32 * 4 * 32;
    constexpr int NITEMS = I_IN + I_OUT + I_GU + I_D;
    for (int it = gw; it < NITEMS; it += NGW) {
        int r = it;
        if (r < I_IN) { const int kb = r / (NIN / 32), nb = r % (NIN / 32);
            p0_transpose_item(w_in, DM, IN_W, WIN, scr, kb * 64, nb * 32, F.lane,
                [](int n) { return n < 2048 ? n : (n < 2560 ? n - 2048 + P_OFF : (n < 2624 ? n - 2560 + IK_OFF : (n < 2632 ? n - 2624 + IW_OFF : -1))); },
                [](int n) { return n; });
            continue; } r -= I_IN;
        if (r < I_OUT) { const int kb = r / 32, nb = r % 32;
            p0_transpose_item(w_out, DM, DM, kb < 8 ? WOUT2 : WOUT, scr, kb * 64, nb * 32, F.lane, [](int n) { return n; }, [](int n) { return n; });
            continue; } r -= I_OUT;
        if (r < I_GU) { const int e = r / 256, bj = (r / 128) & 1, q = r % 128, kb = q / 8, nb = q % 8;
            const float* W = (bj ? w_up : w_gate) + (size_t)e * DM * DEXP;
            p0_transpose_item(W, DM, DEXP, WGU, scr, kb * 64, nb * 32, F.lane, [](int n) { return n; },
                [e, bj](int n) { return e * 512 + (n >> 7) * 256 + bj * 128 + (n & 127); });
            continue; } r -= I_GU;
        { const int e = r / 128, q = r % 128, kb = q / 32, nb = q % 32;
            p0_transpose_item(w_down + (size_t)e * DEXP * DM, DEXP, DM, WD, scr, kb * 64, nb * 32, F.lane, [](int n) { return n; }, [e](int n) { return e * 1024 + n; }); }
    }
    { const int gt = F.vcu * (NWAVES * 64) + F.tid, NGT = F.G * NWAVES * 64;
      for (int i0 = gt; i0 < M * DM / 8; i0 += 4 * NGT) {
          f32x4 a[4], b[4];
#pragma unroll
          for (int u = 0; u < 4; ++u) { const int i = i0 + u * NGT; if (i < M * DM / 8) { a[u] = *(const GAS f32x4*)(x + (size_t)i * 8); b[u] = *(const GAS f32x4*)(x + (size_t)i * 8 + 4); } }
#pragma unroll
          for (int u = 0; u < 4; ++u) { const int i = i0 + u * NGT; if (i < M * DM / 8) {
              v4u o; o.x = pk2(a[u].x, a[u].y); o.y = pk2(a[u].z, a[u].w); o.z = pk2(b[u].x, b[u].y); o.w = pk2(b[u].z, b[u].w); *(GAS v4u*)(XB + (size_t)i * 8) = o; } } }
      for (int i = gt; i < 512 * 64; i += NGT) { const int cg = i / 64, d0 = (i % 64) * 8, g = cg >> 7, c = cg & 127; unsigned short o[8];
#pragma unroll
          for (int j = 0; j < 8; ++j) { const int dg = d0 + j; float v = 0.f; if ((dg >> 7) == g) v = w_pool[((size_t)g * 128 + c) * 128 + (dg & 127)] * pool_scale[dg]; o[j] = (unsigned short)f2bf(v); }
          v4u w; w.x = o[0] | (o[1] << 16); w.y = o[2] | (o[3] << 16); w.z = o[4] | (o[5] << 16); w.w = o[6] | (o[7] << 16); *(GAS v4u*)(WPBD + (size_t)cg * 512 + d0) = w; }
      for (int i = gt; i < 48 * 1024; i += NGT) { const int o = i / 1024, k = i % 1024; const float w = o < 4 ? w_r1[k * 4 + o] : (o < 36 ? w_r2[k * 32 + (o - 4)] : 0.f);
          const unsigned hb = f2bf(w); const float lo = w - __builtin_bit_cast(float, hb << 16); WRT[i] = (bf16_t)hb; WRT[48 * 1024 + i] = (bf16_t)f2bf(lo); }
      for (int i = gt; i < 8 * 1024; i += NGT) { const int h = i / 1024, ii = i % 1024, dist = 448 - ii; float v = 0.f;
          if (dist >= 0 && dist < 128) v = (rel_bias[rel_bucket_dev(dist) * 8 + h] - rel_bias[31 * 8 + h]) * LOG2E;
          BT[i] = v; }
    }
}

template <int W> __device__ __forceinline__ void pool_item(const bf16_t* U, bf16_t* PO  , int row, int ch) {
    const int tpos = row & (SEQ - 1); const int cnt = (tpos + 1) < W ? (tpos + 1) : W;
    v4u v[W];
#pragma unroll
    for (int k = 0; k < W; ++k) { const int kk = k < cnt ? k : 0; v[k] = *(const GAS v4u*)(U + (size_t)(row - kk) * AW + ch * 8); }
    float s[8];
#pragma unroll
    for (int j = 0; j < 8; ++j) s[j] = 0.f;
#pragma unroll
    for (int k = 0; k < W; ++k) { const float m = k < cnt ? 1.f : 0.f; const unsigned ww[4] = {v[k].x, v[k].y, v[k].z, v[k].w};
#pragma unroll
        for (int j = 0; j < 4; ++j) { s[2 * j] += m * __builtin_bit_cast(float, ww[j] << 16); s[2 * j + 1] += m * __builtin_bit_cast(float, ww[j] & 0xffff0000u); } }
    const float inv = 1.f / (float)cnt; const unsigned w0[4] = {v[0].x, v[0].y, v[0].z, v[0].w}; unsigned o[4];
#pragma unroll
    for (int j = 0; j < 4; ++j) o[j] = pk2(s[2 * j] * inv - __builtin_bit_cast(float, w0[j] << 16), s[2 * j + 1] * inv - __builtin_bit_cast(float, w0[j] & 0xffff0000u));
    *(GAS v4u*)(PO + (size_t)row * DM + ch * 8) = (v4u){o[0], o[1], o[2], o[3]};
}
__device__ __forceinline__ void p2_pool(Frame& F) {
    const bf16_t* U = (const bf16_t*)(F.ws + WS_U); bf16_t* PO = (bf16_t*)(F.ws + WS_AP) + AW;
    const int gw = F.vcu * NWAVES + F.wave, NGW = F.G * NWAVES;
#pragma unroll 1
    for (int id = gw; id < M; id += NGW) {
        const int g = id & 3, row = (id >> 2) * 4 + (F.lane >> 4), ch = g * 16 + (F.lane & 15);
        if (g == 0) pool_item<2>(U, PO, row, ch); else if (g == 1) pool_item<4>(U, PO, row, ch); else if (g == 2) pool_item<8>(U, PO, row, ch); else pool_item<16>(U, PO, row, ch);
    }
}

__device__ __forceinline__ int wave_incl_scan(int x) {
    int v = x;
    v += __builtin_amdgcn_update_dpp(0, v, 0x111, 0xf, 0xf, true);
    v += __builtin_amdgcn_update_dpp(0, v, 0x112, 0xf, 0xf, true);
    v += __builtin_amdgcn_update_dpp(0, v, 0x114, 0xf, 0xf, true);
    v += __builtin_amdgcn_update_dpp(0, v, 0x118, 0xf, 0xf, true);
    v += __builtin_amdgcn_update_dpp(0, v, 0x142, 0xa, 0xf, false);
    v += __builtin_amdgcn_update_dpp(0, v, 0x143, 0xc, 0xf, false);
    return v;
}
__device__ __forceinline__ float relu_i(float x) { const int b = __builtin_bit_cast(int, x); return __builtin_bit_cast(float, b > 0 ? b : 0); }
__device__ __forceinline__ unsigned key2(float s0, float s1) {
    const auto hh = __builtin_amdgcn_cvt_pkrtz(s0, s1); unsigned u = __builtin_bit_cast(unsigned, hh);
    const unsigned sg = u & 0x80008000u; const unsigned m = (sg >> 15) * 0xffffu;
    return u ^ (m | 0x80008000u);
}

__device__ __forceinline__ void p2_indexer(Frame& F) {
    const bf16_t* IQ = (const bf16_t*)(F.ws + WS_IQ); const bf16_t* IK = (const bf16_t*)(F.ws + WS_IK); const float* IW = (const float*)(F.ws + WS_IW);
    unsigned* MASKQ = (unsigned*)(F.ws + WS_MASK);
    LAS unsigned short* SC = (LAS unsigned short*)F.lds;
    LAS unsigned* H1 = (LAS unsigned*)(F.lds + LDS_HIST);
    LAS unsigned* H2 = (LAS unsigned*)(F.lds + LDS_WT + F.wave * 256);
    LAS unsigned char* MST = (LAS unsigned char*)(F.lds + LDS_MST);
    const int lane = F.lane, wave = F.wave, fr = lane & 15, fq = lane >> 4;
    constexpr float SSC = 0.04419417382f;
    const int npairs = BATCH * 128;
#pragma unroll 1
    for (int p = F.vcu; p < npairs; p += F.G)
#pragma unroll 1
      for (int half = 0; half < 2; ++half) {
        const int b = p >> 7, s_ = p & 127, qt = half ? 255 - s_ : s_;
        const int t0 = qt * 16; const long rb = (long)b * SEQ;
        for (int i = F.tid; i < 16 * SC_HS / 4; i += NWAVES * 64) ((LAS v4u*)H1)[i] = (v4u){0u, 0u, 0u, 0u};
        bf16x8 bq[8][2]; float wq[8];
#pragma unroll
        for (int j = 0; j < 8; ++j)
#pragma unroll
            for (int ks = 0; ks < 2; ++ks) bq[j][ks] = *(const GAS bf16x8*)(IQ + (size_t)(rb + t0 + fr) * AW + j * 64 + ks * 32 + fq * 8);
        { const f32x4 w0 = *(const GAS f32x4*)(IW + (size_t)(rb + t0 + fr) * 8), w1 = *(const GAS f32x4*)(IW + (size_t)(rb + t0 + fr) * 8 + 4);
          wq[0] = w0.x; wq[1] = w0.y; wq[2] = w0.z; wq[3] = w0.w; wq[4] = w1.x; wq[5] = w1.y; wq[6] = w1.z; wq[7] = w1.w; }
        __syncthreads();
        {
            int kb = wave; const int nkb = qt + 1; bf16x8 an[2];
            const bf16_t* ikp = IK + (size_t)(rb + fr) * 64 + fq * 8;
            if (kb < nkb) { an[0] = *(const GAS bf16x8*)(ikp + (size_t)kb * 1024); an[1] = *(const GAS bf16x8*)(ikp + (size_t)kb * 1024 + 32); }
#pragma unroll 1
            while (kb < nkb) {
                const bf16x8 a0 = an[0], a1 = an[1];
                const int kbn = kb + NWAVES;
                if (kbn < nkb) { an[0] = *(const GAS bf16x8*)(ikp + (size_t)kbn * 1024); an[1] = *(const GAS bf16x8*)(ikp + (size_t)kbn * 1024 + 32); }
                f32x4 acc[8];
#pragma unroll
                for (int j = 0; j < 8; ++j) { acc[j] = (f32x4){0.f, 0.f, 0.f, 0.f};
                    acc[j] = __builtin_amdgcn_mfma_f32_16x16x32_bf16(a0, bq[j][0], acc[j], 0, 0, 0);
                    acc[j] = __builtin_amdgcn_mfma_f32_16x16x32_bf16(a1, bq[j][1], acc[j], 0, 0, 0); }
                float sc[4] = {0.f, 0.f, 0.f, 0.f};
#pragma unroll
                for (int j = 0; j < 8; ++j)
#pragma unroll
                    for (int r = 0; r < 4; ++r) sc[r] = __builtin_fmaf(wq[j], relu_i(acc[j][r]), sc[r]);
                const unsigned k01 = key2(sc[0] * SSC, sc[1] * SSC), k23 = key2(sc[2] * SSC, sc[3] * SSC);
                unsigned k[4] = {k01 & 0xffffu, k01 >> 16, k23 & 0xffffu, k23 >> 16};
                if (kb == qt) {
#pragma unroll
                    for (int r = 0; r < 4; ++r) if (4 * fq + r > fr) k[r] = 0u; }
                *(LAS v2u*)(SC + fr * SC_RS + 16 * kb + 4 * fq) = (v2u){k[0] | (k[1] << 16), k[2] | (k[3] << 16)};
#pragma unroll
                for (int r = 0; r < 4; ++r) LADD(H1 + fr * SC_HS + (k[r] >> 8), (k[r] ? 1u : 0u) << (16 * ((k[r] >> 7) & 1)));
                kb = kbn;
            }
        }
        __syncthreads();
        const int nch = 2 * (qt + 1);
        typedef unsigned short us2 __attribute__((ext_vector_type(2)));
#pragma unroll 1
        for (int qq = 0; qq < 2; ++qq) {
            const int ql = 2 * wave + qq, t = t0 + ql;
            const LAS unsigned short* rowp = SC + ql * SC_RS;
            unsigned v[8][4];
#pragma unroll
            for (int i = 0; i < 8; ++i) { const int c = i * 64 + lane; const v4u x = *(const LAS v4u*)(rowp + 8 * c); const unsigned mk = (c < nch) ? 0xffffffffu : 0u; v[i][0] = x.x & mk; v[i][1] = x.y & mk; v[i][2] = x.z & mk; v[i][3] = x.w & mk; }
            unsigned T = 1u; int need_eq = 0, n_eq = 0; const bool all = (t + 1 <= 256);
            if (!all) {
                const int lr = 63 - lane;
                unsigned hw[4]; { const v4u h0 = *(const LAS v4u*)(H1 + ql * SC_HS + 4 * lr); hw[0] = h0.x; hw[1] = h0.y; hw[2] = h0.z; hw[3] = h0.w; }
                int sl = 0;
#pragma unroll
                for (int w = 0; w < 4; ++w) sl += (int)(hw[w] & 0xffffu) + (int)(hw[w] >> 16);
                const int incl = wave_incl_scan(sl), above = incl - sl;
                int fb = -1, fa = 0; { int run = above;
#pragma unroll
                    for (int bb = 7; bb >= 0; --bb) { const int c = (int)((hw[bb >> 1] >> (16 * (bb & 1))) & 0xffffu); if (fb < 0 && run + c >= 256) { fb = bb; fa = run; } run += c; } }
                const bool cross = (above < 256) && (incl >= 256);
                const unsigned long long bm = __ballot(cross); const int src = bm ? (int)__builtin_ctzll(bm) : 0;
                const int B1 = __builtin_amdgcn_readlane(8 * lr + fb, src), cnt_above = __builtin_amdgcn_readlane(fa, src);
                const unsigned Tlo = (unsigned)B1 << 7;
                H2[lane] = 0u; LDS_WAIT();
#pragma unroll
                for (int i = 0; i < 8; ++i)
#pragma unroll
                    for (int w = 0; w < 4; ++w) { const unsigned x = v[i][w]; const unsigned k0 = x & 0xffffu, k1 = x >> 16;
                        const bool c0 = (k0 >> 7) == (unsigned)B1, c1 = (k1 >> 7) == (unsigned)B1;
                        if (__ballot(c0 || c1)) { LADD(H2 + ((k0 & 127u) >> 1), (c0 ? 1u : 0u) << (16 * (k0 & 1u))); LADD(H2 + ((k1 & 127u) >> 1), (c1 ? 1u : 0u) << (16 * (k1 & 1u))); } }
                LDS_WAIT();
                const int need2 = 256 - cnt_above;
                const unsigned w2 = H2[lr]; const int c_lo = (int)(w2 & 0xffffu), c_hi = (int)(w2 >> 16), sl2 = c_lo + c_hi;
                const int incl2 = wave_incl_scan(sl2), ab2 = incl2 - sl2;
                const bool cross2 = (ab2 < need2) && (incl2 >= need2);
                const bool inhi = (ab2 + c_hi >= need2);
                const int myB2 = 2 * lr + (inhi ? 1 : 0), myab = inhi ? ab2 : ab2 + c_hi, myeq = inhi ? c_hi : c_lo;
                const unsigned long long bm2 = __ballot(cross2); const int src2 = bm2 ? (int)__builtin_ctzll(bm2) : 0;
                const int B2 = __builtin_amdgcn_readlane(myB2, src2), above2 = __builtin_amdgcn_readlane(myab, src2);
                n_eq = __builtin_amdgcn_readlane(myeq, src2);
                T = Tlo | (unsigned)B2;
                need_eq = need2 - above2;
                LDS_WAIT();
            }
            const bool ties = (!all) && (need_eq < n_eq);
            if (!ties) {
                const unsigned tm1 = (T - 1u) | ((T - 1u) << 16);
#pragma unroll
                for (int i = 0; i < 8; ++i) { unsigned sel = 0u;
#pragma unroll
                    for (int w = 0; w < 4; ++w) { const us2 d = __builtin_elementwise_sub_sat(__builtin_bit_cast(us2, v[i][w]), __builtin_bit_cast(us2, tm1));
                        const us2 one = {1, 1}; const unsigned m = __builtin_bit_cast(unsigned, __builtin_elementwise_min(d, one));
                        sel |= ((m | (m >> 15)) & 3u) << (2 * w); }
                    MST[ql * 512 + i * 64 + lane] = (unsigned char)sel; }
            } else {
                int tie_base = 0;
#pragma unroll
                for (int i = 0; i < 8; ++i) {
                    unsigned gt_bits = 0u, eq_bits = 0u;
#pragma unroll
                    for (int w = 0; w < 4; ++w) { const unsigned x = v[i][w]; const unsigned k0 = x & 0xffffu, k1 = x >> 16;
                        gt_bits |= (k0 > T ? 1u : 0u) << (2 * w); gt_bits |= (k1 > T ? 1u : 0u) << (2 * w + 1);
                        eq_bits |= (k0 == T ? 1u : 0u) << (2 * w); eq_bits |= (k1 == T ? 1u : 0u) << (2 * w + 1); }
                    const int pc = __builtin_popcount(eq_bits);
                    const int incl = wave_incl_scan(pc);
                    const int excl = tie_base + incl - pc;
                    unsigned keep = 0u; int rk = excl;
#pragma unroll
                    for (int e = 0; e < 8; ++e) { if ((eq_bits >> e) & 1u) { if (rk < need_eq) keep |= 1u << e; ++rk; } }
                    tie_base += __builtin_amdgcn_readlane(incl, 63);
                    MST[ql * 512 + i * 64 + lane] = (unsigned char)(gt_bits | keep);
                }
            }
        }
        __syncthreads();
        { const v4u mv = *(const LAS v4u*)(MST + F.tid * 16); *(GAS v4u*)((unsigned char*)MASKQ + (size_t)(rb + t0) * 512 + F.tid * 16) = mv; }
        __syncthreads();
      }
}

constexpr int P5_RS = 2064;
__device__ __forceinline__ void p5_ln1_router(Frame& F, const Args& A) {
    const float* x = inp(0); const float* g1 = inp(6); const float* b1 = inp(7); const float* b_r1 = inp(9); const float* b_r2 = inp(11);
    const float* MIX = (const float*)(F.ws + WS_MIX); float* H1 = F.out; bf16_t* H1B = (bf16_t*)(F.ws + WS_H1B);
    int* RE = (int*)(F.ws + WS_RE); float* RW = (float*)(F.ws + WS_RW);
    const bf16_t* WRT = (const bf16_t*)(F.ws + WS_WRT);
    LAS unsigned char* HI = F.lds; LAS unsigned char* LO = F.lds + 32 * P5_RS;
    LAS float* RED = (LAS float*)F.lds;
    LAS float* LG = (LAS float*)(F.lds + 135168);
    LAS int* lcnt = (LAS int*)(F.lds + LDS_TBL + 1024);
    const int lane = F.lane, wave = F.wave, fr = lane & 15, fq = lane >> 4;
    if (F.tid < 32) lcnt[F.tid] = 0;
    bf16x8 bw[4][3][2];
#pragma unroll
    for (int ks = 0; ks < 4; ++ks)
#pragma unroll
        for (int nt = 0; nt < 3; ++nt)
#pragma unroll
            for (int p = 0; p < 2; ++p) bw[ks][nt][p] = *(const GAS bf16x8*)(WRT + (size_t)p * 48 * 1024 + (size_t)(nt * 16 + fr) * 1024 + wave * 128 + ks * 32 + fq * 8);
    f32x4 gg[4], bb[4];
#pragma unroll
    for (int j = 0; j < 4; ++j) { gg[j] = *(const GAS f32x4*)(g1 + 256 * j + 4 * lane); bb[j] = *(const GAS f32x4*)(b1 + 256 * j + 4 * lane); }
    for (int blk = F.vcu; blk < M / 32; blk += F.G) {
        __syncthreads();
#pragma unroll 1
        for (int rp = 0; rp < 2; ++rp) {
            f32x4 v[2][4];
#pragma unroll
            for (int rr = 0; rr < 2; ++rr) { const size_t m = (size_t)blk * 32 + wave * 4 + rp * 2 + rr;
#pragma unroll
                for (int j = 0; j < 4; ++j) { const f32x4 xv = *(const GAS f32x4*)(x + m * DM + 256 * j + 4 * lane), mv = *(const GAS f32x4*)(MIX + m * DM + 256 * j + 4 * lane); v[rr][j] = xv * ALPHA + mv; } }
#pragma unroll
            for (int rr = 0; rr < 2; ++rr) { const int rl = wave * 4 + rp * 2 + rr; const size_t m = (size_t)blk * 32 + rl;
                float s = 0.f;
#pragma unroll
                for (int j = 0; j < 4; ++j) s += (v[rr][j].x + v[rr][j].y) + (v[rr][j].z + v[rr][j].w);
                const float mean = wave_sum(s) * (1.f / DM); float s2 = 0.f;
#pragma unroll
                for (int j = 0; j < 4; ++j) { v[rr][j] = v[rr][j] - mean; s2 += (v[rr][j].x * v[rr][j].x + v[rr][j].y * v[rr][j].y) + (v[rr][j].z * v[rr][j].z + v[rr][j].w * v[rr][j].w); }
                const float rstd = 1.f / sqrtf(wave_sum(s2) * (1.f / DM) + LN_EPS);
#pragma unroll
                for (int j = 0; j < 4; ++j) { const f32x4 h = v[rr][j] * rstd * gg[j] + bb[j];
                    *(GAS f32x4*)(H1 + m * DM + 256 * j + 4 * lane) = h;
                    const unsigned h0 = f2bf(h.x), h1 = f2bf(h.y), h2 = f2bf(h.z), h3 = f2bf(h.w);
                    v2u o; o.x = h0 | (h1 << 16); o.y = h2 | (h3 << 16); *(GAS v2u*)(H1B + m * DM + 256 * j + 4 * lane) = o;
                    *(LAS v2u*)(HI + rl * P5_RS + (256 * j + 4 * lane) * 2) = o;
                    v2u l; l.x = pk2(h.x - __builtin_bit_cast(float, h0 << 16), h.y - __builtin_bit_cast(float, h1 << 16)); l.y = pk2(h.z - __builtin_bit_cast(float, h2 << 16), h.w - __builtin_bit_cast(float, h3 << 16));
                    *(LAS v2u*)(LO + rl * P5_RS + (256 * j + 4 * lane) * 2) = l; } }
        }
        __syncthreads();
        f32x4 acc[2][3];
#pragma unroll
        for (int mt = 0; mt < 2; ++mt)
#pragma unroll
            for (int nt = 0; nt < 3; ++nt) acc[mt][nt] = (f32x4){0.f, 0.f, 0.f, 0.f};
#pragma unroll
        for (int ks = 0; ks < 4; ++ks) {
            bf16x8 ah[2], al[2];
#pragma unroll
            for (int mt = 0; mt < 2; ++mt) { const int off = (mt * 16 + fr) * P5_RS + (wave * 128 + ks * 32 + fq * 8) * 2; ah[mt] = *(const LAS bf16x8*)(HI + off); al[mt] = *(const LAS bf16x8*)(LO + off); }
#pragma unroll
            for (int mt = 0; mt < 2; ++mt)
#pragma unroll
                for (int nt = 0; nt < 3; ++nt) {
                    acc[mt][nt] = __builtin_amdgcn_mfma_f32_16x16x32_bf16(ah[mt], bw[ks][nt][0], acc[mt][nt], 0, 0, 0);
                    acc[mt][nt] = __builtin_amdgcn_mfma_f32_16x16x32_bf16(ah[mt], bw[ks][nt][1], acc[mt][nt], 0, 0, 0);
                    acc[mt][nt] = __builtin_amdgcn_mfma_f32_16x16x32_bf16(al[mt], bw[ks][nt][0], acc[mt][nt], 0, 0, 0); }
        }
        __syncthreads();
#pragma unroll
        for (int mt = 0; mt < 2; ++mt)
#pragma unroll
            for (int nt = 0; nt < 3; ++nt)
#pragma unroll
                for (int r = 0; r < 4; ++r) RED[(wave * 32 + mt * 16 + 4 * fq + r) * 48 + nt * 16 + fr] = acc[mt][nt][r];
        __syncthreads();
        for (int i = F.tid; i < 32 * 36; i += NWAVES * 64) { const int row = i / 36, o = i % 36; float sum = 0.f;
#pragma unroll
            for (int w = 0; w < 8; ++w) sum += RED[(w * 32 + row) * 48 + o];
            LG[row * 36 + o] = sum; }
        __syncthreads();
        if (F.tid < 32) {
            const int row = F.tid; const size_t m = (size_t)blk * 32 + row; const LAS float* lg = LG + row * 36;
            float l4[4]; int g = 0; float mx = -INFINITY;
#pragma unroll
            for (int i = 0; i < 4; ++i) { l4[i] = lg[i] + b_r1[i]; if (l4[i] > mx) { mx = l4[i]; g = i; } }
            float z = 0.f;
#pragma unroll
            for (int i = 0; i < 4; ++i) z += expf(l4[i] - mx);
            const float pg_top = 1.f / z;
            float l8[8];
#pragma unroll
            for (int e = 0; e < 8; ++e) l8[e] = lg[4 + g * 8 + e] + b_r2[g * 8 + e];
            int e0 = 0; float m0 = -INFINITY;
#pragma unroll
            for (int e = 0; e < 8; ++e) if (l8[e] > m0) { m0 = l8[e]; e0 = e; }
            int e1 = 0; float m1 = -INFINITY;
#pragma unroll
            for (int e = 0; e < 8; ++e) if (e != e0 && l8[e] > m1) { m1 = l8[e]; e1 = e; }
            const float r = expf(m1 - m0); const float w0 = pg_top / (1.f + r), w1 = pg_top * r / (1.f + r);
            RE[2 * m] = g * 8 + e0; RE[2 * m + 1] = g * 8 + e1; RW[2 * m] = w0; RW[2 * m + 1] = w1;
            LADD(lcnt + g * 8 + e0, 1); LADD(lcnt + g * 8 + e1, 1);
        }
    }
    __syncthreads();
    if (F.tid < 32) { const int c = lcnt[F.tid]; if (c) __hip_atomic_fetch_add((unsigned*)(F.ctl + CW_CNT + F.tid), (unsigned)c, RLX_AGENT); }
}

__device__ __forceinline__ int moe_table(Frame& F) {
    LAS int* toff = (LAS int*)(F.lds + LDS_TBL); LAS int* tile_e = toff + 40;
    __syncthreads();
    if (F.tid == 0) { int acc = 0; for (int e = 0; e < 32; ++e) { toff[e] = acc; const unsigned n = __hip_atomic_load((unsigned*)(F.ctl + CW_CNT + e), RLX_AGENT); acc += (int)((n + 255u) >> 8); } toff[32] = acc; }
    __syncthreads();
    const int RT = toff[32];
    if (F.tid < 32) { for (int k = toff[F.tid]; k < toff[F.tid + 1]; ++k) tile_e[k] = F.tid; }
    __syncthreads();
    return RT < 160 ? RT : 160;
}

__device__ __forceinline__ void p6_positions(Frame& F) {
    (void)moe_table(F);
    LAS int* toff = (LAS int*)(F.lds + LDS_TBL); LAS int* lcnt = (LAS int*)(F.lds + LDS_TBL + 1024); LAS int* base = lcnt + 32;
    const int* RE = (const int*)(F.ws + WS_RE); const float* RW = (const float*)(F.ws + WS_RW); int* POS = (int*)(F.ws + WS_POS); float* WROW = (float*)(F.ws + WS_WROW);
    int* rowidx = (int*)(F.ctl + CW_ROWIDX);
    for (int chunk = F.vcu; chunk < M / 64; chunk += F.G) {
        if (F.tid < 32) lcnt[F.tid] = 0;
        __syncthreads();
        int e = 0, r = 0, tok = 0;
        if (F.tid < 128) { tok = chunk * 64 + (F.tid >> 1); e = RE[2 * tok + (F.tid & 1)]; r = LADD(lcnt + e, 1); }
        __syncthreads();
        if (F.tid < 32) { const int c = lcnt[F.tid]; base[F.tid] = c ? (int)__hip_atomic_fetch_add((unsigned*)(F.ctl + CW_CUR + F.tid), (unsigned)c, RLX_AGENT) : 0; }
        __syncthreads();
        if (F.tid < 128) { const int pos = toff[e] * 256 + base[e] + r; if (pos < MAXROWS) { rowidx[pos] = tok; WROW[pos] = RW[2 * tok + (F.tid & 1)]; } POS[2 * tok + (F.tid & 1)] = pos; }
        __syncthreads();
    }
}

__device__ __forceinline__ void p9_ln2(Frame& F, const Args& A) {
    const float* g2 = inp(15); const float* b2 = inp(16);
    float* H1 = F.out; const bf16_t* YS = (const bf16_t*)(F.ws + WS_YS); const int* POS = (const int*)(F.ws + WS_POS);
    const int lane = F.lane; const int gw = F.vcu * NWAVES + F.wave, NGW = F.G * NWAVES;
    f32x4 gg[4], bb[4];
#pragma unroll
    for (int j = 0; j < 4; ++j) { gg[j] = *(const GAS f32x4*)(g2 + 256 * j + 4 * lane); bb[j] = *(const GAS f32x4*)(b2 + 256 * j + 4 * lane); }
    for (int m = gw; m < M; m += NGW) {
        const int p0 = POS[2 * m], p1 = POS[2 * m + 1];
        f32x4 v[4]; float s = 0.f;
#pragma unroll
        for (int j = 0; j < 4; ++j) { const f32x4 hv = *(const GAS f32x4*)(H1 + (size_t)m * DM + 256 * j + 4 * lane);
            const v2u y0 = *(const GAS v2u*)(YS + (size_t)p0 * DM + 256 * j + 4 * lane), y1 = *(const GAS v2u*)(YS + (size_t)p1 * DM + 256 * j + 4 * lane);
            f32x4 yy; yy.x = __builtin_bit_cast(float, y0.x << 16) + __builtin_bit_cast(float, y1.x << 16); yy.y = __builtin_bit_cast(float, y0.x & 0xffff0000u) + __builtin_bit_cast(float, y1.x & 0xffff0000u);
            yy.z = __builtin_bit_cast(float, y0.y << 16) + __builtin_bit_cast(float, y1.y << 16); yy.w = __builtin_bit_cast(float, y0.y & 0xffff0000u) + __builtin_bit_cast(float, y1.y & 0xffff0000u);
            v[j] = hv * ALPHA + yy; s += (v[j].x + v[j].y) + (v[j].z + v[j].w); }
        const float mean = wave_sum(s) * (1.f / DM); float s2 = 0.f;
#pragma unroll
        for (int j = 0; j < 4; ++j) { v[j] = v[j] - mean; s2 += (v[j].x * v[j].x + v[j].y * v[j].y) + (v[j].z * v[j].z + v[j].w * v[j].w); }
        const float rstd = 1.f / sqrtf(wave_sum(s2) * (1.f / DM) + LN_EPS);
#pragma unroll
        for (int j = 0; j < 4; ++j) *(GAS f32x4*)(H1 + (size_t)m * DM + 256 * j + 4 * lane) = v[j] * rstd * gg[j] + bb[j];
    }
}

constexpr int N_PHASES = 10;
__global__ void __launch_bounds__(NWAVES * 64, 2) fwd_kernel(Args args) {
    extern __shared__ __attribute__((aligned(16))) unsigned char lds[];
    Frame F;
    F.lds = (LAS unsigned char*)lds;
    F.tid = threadIdx.x; F.lane = F.tid & 63; F.wave = __builtin_amdgcn_readfirstlane(F.tid >> 6);
    F.G = gridDim.x; { const int bx = blockIdx.x; F.vcu = (F.G % 8 == 0) ? (bx % 8) * (F.G / 8) + bx / 8 : bx; }
    F.ws = args.ws; F.ctl = (gu32*)(args.ws + WS_CTL); F.out = args.out;
    volatile LAS unsigned* MISC = (volatile LAS unsigned*)(F.lds + LDS_MISC);
    if (F.tid < 32) MISC[F.tid] = 0u;
    __syncthreads();
    const int lo = args.ph_lo, hi = args.ph_hi;
    const bool one = (hi - lo) > 1;
    unsigned* barw = (unsigned*)(F.ctl + CW_BAR) + args.bar_region * XCD_BAR_WORDS;
    XcdBarrier bar; bar.bar = barw; bar.x = 0; bar.st = nullptr;
    if (one) bar = xcd_barrier_post(barw, MISC + 8);
#ifndef PHASE_MASK
#define PHASE_MASK 0x3ff
#endif
#define IN(k) (((PHASE_MASK >> (k)) & 1) && lo <= (k) && (k) < hi)
#define SEAM(k) do { if (IN(k) && IN((k) + 1)) xcd_barrier(bar); } while (0)

    if (IN(0)) { p0_prologue(F, args); } SEAM(0);

    if (IN(1)) {
        pg8::Gemm g{(const bf16_t*)(F.ws + WS_XB), (const bf16_t*)(F.ws + WS_WIN), DM, nullptr, DM}; pg8::StaticOrder S; S.init(M, NIN, F.G, (int)blockIdx.x);
        pg8::EpiInProj E{(bf16_t*)(F.ws + WS_Q), (bf16_t*)(F.ws + WS_IK), (float*)(F.ws + WS_IW)};
        pg8::gemm_phase<pg8::EpiInProj, pg8::StaticOrder, true>(F.lds, g, S, E);
        { const int j = (int)blockIdx.x - (F.G - 8);
          pg8::OneUnit S1{j >> 1, j & 1, j >= 0 && j < 8};
          pg8::Gemm g1{(const bf16_t*)(F.ws + WS_WOUT) + AW, (const bf16_t*)(F.ws + WS_WPBD), AW, nullptr, DM};
          pg8::EpiBf16Plain E1{(bf16_t*)(F.ws + WS_WOUT2), DM, AW};
          pg8::gemm_phase<pg8::EpiBf16Plain, pg8::OneUnit, true>(F.lds, g1, S1, E1); }
    } SEAM(1);

    if (IN(2)) { p2_pool(F); p2_indexer(F); } SEAM(2);

    if (IN(3)) {
        const float* BT = (const float*)(F.ws + WS_BIAS);
        LAS float* btab = (LAS float*)(F.lds + LDS_BIAS);
        for (int v = F.vcu; v < 256; v += F.G) {
            const int bh = v >> 3, s = v & 7, b = bh >> 3, h = bh & 7;
            __syncthreads();
            for (int i = F.tid; i < 1024; i += NWAVES * 64) btab[i] = BT[h * 1024 + i];
            __syncthreads();
            for (int k = 0; k < 2; ++k) {
                const int qb = k ? 15 - s : s;
                attn_body::attn_unit<8>(b, h, qb, (const attn_body::bf16*)(F.ws + WS_Q), (const attn_body::bf16*)(F.ws + WS_K), (const attn_body::bf16*)(F.ws + WS_V),
                                        (attn_body::bf16*)(F.ws + WS_AP), (const unsigned*)(F.ws + WS_MASK), btab, (char*)lds);
            }
        }
    } SEAM(3);

    if (IN(4)) {
        pg8::Gemm g{(const bf16_t*)(F.ws + WS_AP), (const bf16_t*)(F.ws + WS_WOUT2), DM, nullptr, DM}; pg8::StaticOrder S; S.init(M, DM, F.G, (int)blockIdx.x);
        pg8::EpiF32 E{(float*)(F.ws + WS_MIX), DM};
        pg8::gemm_phase<pg8::EpiF32, pg8::StaticOrder, true>(F.lds, g, S, E);
    } SEAM(4);

    if (IN(5)) { p5_ln1_router(F, args); } SEAM(5);

    if (IN(6)) { p6_positions(F); } SEAM(6);

    if (IN(7)) {
        const int RT = moe_table(F);
        pg8::Gemm g{(const bf16_t*)(F.ws + WS_H1B), (const bf16_t*)(F.ws + WS_WGU), DM, (const int*)(F.ctl + CW_ROWIDX), DM};
        pg8::MoeOrder<2> S{(const LAS int*)(F.lds + LDS_TBL) + 40, RT, F.G, (int)blockIdx.x};
        pg8::EpiGateUp E{(bf16_t*)(F.ws + WS_ACT)};
        pg8::gemm_phase<pg8::EpiGateUp, pg8::MoeOrder<2>, true, true>(F.lds, g, S, E);
    } SEAM(7);

    if (IN(8)) {
        const int RT = moe_table(F);
        pg8::Gemm g{(const bf16_t*)(F.ws + WS_ACT), (const bf16_t*)(F.ws + WS_WD), DEXP, nullptr, DEXP};
        pg8::MoeOrder<4> S{(const LAS int*)(F.lds + LDS_TBL) + 40, RT, F.G, (int)blockIdx.x};
        pg8::EpiDown E{(bf16_t*)(F.ws + WS_YS), (const float*)(F.ws + WS_WROW)};
        pg8::gemm_phase<pg8::EpiDown, pg8::MoeOrder<4>, true>(F.lds, g, S, E);
    } SEAM(8);

    if (IN(9)) { p9_ln2(F, args); }
#undef IN
#undef SEAM
}

extern "C" void kernel_launch(void* const* d_in, const int* in_sizes, int n_in, void* d_out, int out_size, void* d_ws, size_t ws_size, hipStream_t stream) {
    static int grid = 0;
    if (grid == 0) {
        if (n_in != 17 || out_size != M * DM || ws_size < WS_END) { fprintf(stderr, "kernel_launch: unexpected shapes (n_in %d out %d ws %zu)\n", n_in, out_size, ws_size); grid = -1; return; }
        int dev = 0, cus = 0, per_cu = 0;
        if (hipGetDevice(&dev) != hipSuccess || hipDeviceGetAttribute(&cus, hipDeviceAttributeMultiprocessorCount, dev) != hipSuccess) { grid = -1; return; }
        if (hipFuncSetAttribute((const void*)fwd_kernel, hipFuncAttributeMaxDynamicSharedMemorySize, LDS_BYTES) != hipSuccess) { fprintf(stderr, "kernel_launch: hipFuncSetAttribute failed\n"); grid = -1; return; }
        if (hipOccupancyMaxActiveBlocksPerMultiprocessor(&per_cu, (const void*)fwd_kernel, NWAVES * 64, LDS_BYTES) != hipSuccess || per_cu < 1)
            fprintf(stderr, "kernel_launch: note: occupancy query reports %d workgroups per CU\n", per_cu);
        (void)hipGetLastError();
        grid = cus;
    }
    if (grid < 0) return;
    (void)hipMemsetAsync((char*)d_ws + WS_CTL, 0, CTL_ZERO_BYTES, stream);
    Args a{};
    for (int i = 0; i < 17; ++i) a.in[i] = (const float*)d_in[i];
    a.out = (float*)d_out; a.ws = (unsigned char*)d_ws;
#if defined(PROBE_REP)
    a.ph_lo = 0; a.ph_hi = PROBE_REP + 1; a.bar_region = 0; hipLaunchKernelGGL(fwd_kernel, dim3(grid), dim3(NWAVES * 64), LDS_BYTES, stream, a);
    a.ph_lo = PROBE_REP; a.ph_hi = PROBE_REP + 1; a.bar_region = 1; hipLaunchKernelGGL(fwd_kernel, dim3(grid), dim3(NWAVES * 64), LDS_BYTES, stream, a);
    a.ph_lo = PROBE_REP + 1; a.ph_hi = N_PHASES; a.bar_region = 2; hipLaunchKernelGGL(fwd_kernel, dim3(grid), dim3(NWAVES * 64), LDS_BYTES, stream, a);
#elif MK_N_LAUNCHES == 1
    a.ph_lo = 0; a.ph_hi = N_PHASES;
    hipLaunchKernelGGL(fwd_kernel, dim3(grid), dim3(NWAVES * 64), LDS_BYTES, stream, a);
#else
    for (int p = 0; p < N_PHASES; ++p) { a.ph_lo = p; a.ph_hi = p + 1; hipLaunchKernelGGL(fwd_kernel, dim3(grid), dim3(NWAVES * 64), LDS_BYTES, stream, a); }
#endif
}
```
